# Optimizing an MI355X kernel written in HIP

```python
import math
import jax
import jax.numpy as jnp
from jax import lax
import numpy as np

D_MODEL = 2048
BATCH = 16
SEQ = 256
DEPTH = 4
DEC_BATCH = 2
DEC_SEQ = 2048
PAST_LEN = 512

GRID_W = 64
HEAD_DIM = 128
N_HEADS = D_MODEL // HEAD_DIM
A_HEADS = (3 * N_HEADS) // 8
A_KV = A_HEADS // 3
B_HEADS = N_HEADS // 4
B_QK_DIM = HEAD_DIM // 2
C_HEADS = N_HEADS - A_HEADS - B_HEADS
C_KV = C_HEADS // 3
MIX_WIDTH = N_HEADS * HEAD_DIM
D_FF = 5632
WINDOW = 128
Q_BLOCK = 128
ROPE_THETA = 10000.0
EPS = 1e-6
FFN_RESID = 0.5
N_SUB = 3
SPLIT_SIZES = (A_HEADS * HEAD_DIM, A_KV * HEAD_DIM, A_KV * HEAD_DIM,
               B_HEADS * 2 * B_QK_DIM, B_HEADS * 2 * B_QK_DIM, B_HEADS * HEAD_DIM,
               C_HEADS * HEAD_DIM, C_KV * HEAD_DIM, C_KV * HEAD_DIM)
IN_WIDTH = sum(SPLIT_SIZES)

kernel_name = "hybrid_prefix_diffusion_step"


def rms_norm(x, g):
    xf = x.astype(jnp.float32)
    y = xf * lax.rsqrt(jnp.mean(xf * xf, axis=-1, keepdims=True) + EPS)
    return (y * g.astype(jnp.float32)).astype(x.dtype)


def swiglu(h, wg, wu, wd):
    return (jax.nn.silu(h @ wg) * (h @ wu)) @ wd


def axial_rope_tables(n_tokens, dim):
    rows = n_tokens // GRID_W
    row = jnp.repeat(jnp.arange(rows, dtype=jnp.float32), GRID_W)
    col = jnp.tile(jnp.arange(GRID_W, dtype=jnp.float32), rows)
    nf = dim // 4
    inv = ROPE_THETA ** (-jnp.arange(nf, dtype=jnp.float32) / nf)
    ang = jnp.concatenate([row[:, None] * inv, col[:, None] * inv], axis=-1)
    return jnp.cos(ang), jnp.sin(ang)


def apply_rope(x, cos, sin):
    x1, x2 = jnp.split(x, 2, axis=-1)
    c = cos[:, None, :].astype(x.dtype)
    s = sin[:, None, :].astype(x.dtype)
    return jnp.concatenate([x1 * c - x2 * s, x2 * c + x1 * s], axis=-1)


def attn_probs(q, k, mask=None, sink=None):
    scale = q.shape[-1] ** -0.5
    s = jnp.einsum("bqhgd,bkhd->bhgqk", q, k, preferred_element_type=jnp.float32) * scale
    if mask is not None:
        s = jnp.where(mask, s, -jnp.inf)
    if sink is None:
        return jax.nn.softmax(s, axis=-1)
    sk = sink.astype(jnp.float32)[None, :, :, None, None]
    m = jnp.maximum(jnp.max(s, axis=-1, keepdims=True), sk)
    e = jnp.exp(s - m)
    return e / (jnp.sum(e, axis=-1, keepdims=True) + jnp.exp(sk - m))


def weighted_values(p, v):
    return jnp.einsum("bhgqk,bkhd->bqhgd", p.astype(v.dtype), v)


def map_query_blocks(fn, *qs):
    b_, l_ = qs[0].shape[:2]
    nb = l_ // Q_BLOCK
    blocks = tuple(jnp.moveaxis(q.reshape((b_, nb, Q_BLOCK) + q.shape[2:]), 1, 0) for q in qs)
    out = lax.map(lambda a: fn(a[0], *a[1:]), (jnp.arange(nb),) + blocks)
    out = jnp.moveaxis(out, 0, 1)
    return out.reshape((b_, l_) + out.shape[3:])


def dense_gqa(q, k, v, sink=None):
    b_, l_, hq, d = q.shape
    kv = k.shape[2]
    qg = q.reshape(b_, l_, kv, hq // kv, d)

    def blk(i, qb):
        return weighted_values(attn_probs(qb, k, None, sink), v)

    return map_query_blocks(blk, qg).reshape(b_, l_, hq * v.shape[-1])


def window_gqa(q, k, v, k_ctx, v_ctx, sink):
    b_, l_, hq, d = q.shape
    kv = k.shape[2]
    qg = q.reshape(b_, l_, kv, hq // kv, d)
    pad = ((0, 0), (WINDOW, WINDOW), (0, 0), (0, 0))
    k_pad = jnp.pad(k, pad)
    v_pad = jnp.pad(v, pad)
    band = Q_BLOCK + 2 * WINDOW
    ctx_mask = jnp.ones((Q_BLOCK, k_ctx.shape[1]), dtype=bool)

    def blk(i, qb):
        start = i * Q_BLOCK
        k_loc = lax.dynamic_slice_in_dim(k_pad, start, band, axis=1)
        v_loc = lax.dynamic_slice_in_dim(v_pad, start, band, axis=1)
        qpos = start + jnp.arange(Q_BLOCK)
        kpos = start - WINDOW + jnp.arange(band)
        local = (jnp.abs(qpos[:, None] - kpos[None, :]) <= WINDOW) & (kpos >= 0)[None, :] & (kpos < l_)[None, :]
        mask = jnp.concatenate([ctx_mask, local], axis=1)
        kk = jnp.concatenate([k_ctx, k_loc], axis=1)
        vv = jnp.concatenate([v_ctx, v_loc], axis=1)
        return weighted_values(attn_probs(qb, kk, mask, sink), vv)

    return map_query_blocks(blk, qg).reshape(b_, l_, hq * d)


def diff_lambda(bl, lam_init):
    bl = bl.astype(jnp.float32)
    return jnp.exp(jnp.sum(bl[0] * bl[1])) - jnp.exp(jnp.sum(bl[2] * bl[3])) + lam_init


def diff_attn(q, k, v, lam, lam_init, g_sub):
    b_, l_, h, _ = q.shape
    q1 = q[..., None, :B_QK_DIM]
    q2 = q[..., None, B_QK_DIM:]
    k1 = k[..., :B_QK_DIM]
    k2 = k[..., B_QK_DIM:]

    def blk(i, q1b, q2b):
        p = attn_probs(q1b, k1) - lam * attn_probs(q2b, k2)
        return weighted_values(p, v)

    o = map_query_blocks(blk, q1, q2)[:, :, :, 0]
    o = rms_norm(o, g_sub) * (1.0 - lam_init)
    return o.reshape(b_, l_, h * HEAD_DIM)


def project(h, w_in_l, qn_g, kn_g):
    b_, l_, _ = h.shape
    p = h @ w_in_l
    parts, off = [], 0
    for size in SPLIT_SIZES:
        parts.append(p[..., off:off + size])
        off += size
    qa, ka, va, qb, kb, vb, qc, kc, vc = parts

    def heads(t, n):
        return t.reshape(b_, l_, n, -1)

    return (heads(qa, A_HEADS), heads(ka, A_KV), heads(va, A_KV),
            heads(qb, B_HEADS), heads(kb, B_HEADS), heads(vb, B_HEADS),
            rms_norm(heads(qc, C_HEADS), qn_g), rms_norm(heads(kc, C_KV), kn_g), heads(vc, C_KV))


def context_mixer(h, w_in_l, w_out_l, sink_l, lam, lam_init, sub_g, qn_g, kn_g):
    qa, ka, va, qb, kb, vb, qc, kc, vc = project(h, w_in_l, qn_g, kn_g)
    oa = dense_gqa(qa, ka, va, sink_l.reshape(A_KV, -1))
    ob = diff_attn(qb, kb, vb, lam, lam_init, sub_g)
    oc = dense_gqa(qc, kc, vc)
    o = jnp.concatenate([oa, ob, oc], axis=-1) @ w_out_l
    return o, (ka, va, kb, vb, kc, vc)


def latent_mixer(h, ctx_kv, rope_hd, rope_qk, w_in_l, w_out_l, sink_l, lam, lam_init, sub_g, qn_g, kn_g):
    b_, l_, _ = h.shape
    qa, ka, va, qb, kb, vb, qc, kc, vc = project(h, w_in_l, qn_g, kn_g)
    cos1, sin1 = rope_hd
    cos2, sin2 = rope_qk
    qa, ka, qc, kc = [apply_rope(t, cos1, sin1) for t in (qa, ka, qc, kc)]
    qb, kb = [apply_rope(t.reshape(b_, l_, 2 * B_HEADS, B_QK_DIM), cos2, sin2).reshape(b_, l_, B_HEADS, 2 * B_QK_DIM)
              for t in (qb, kb)]
    cka, cva, ckb, cvb, ckc, cvc = ctx_kv
    oa = window_gqa(qa, ka, va, cka, cva, sink_l.reshape(A_KV, -1))
    ob = diff_attn(qb, jnp.concatenate([ckb, kb], axis=1), jnp.concatenate([cvb, vb], axis=1), lam, lam_init, sub_g)
    oc = dense_gqa(qc, jnp.concatenate([ckc, kc], axis=1), jnp.concatenate([cvc, vc], axis=1))
    o = jnp.concatenate([oa, ob, oc], axis=-1) @ w_out_l
    return o, None


def adaln(cond, w, b):
    m = jax.nn.silu(cond) @ w + b
    return m.reshape(cond.shape[0], 1, 3 * N_SUB, D_MODEL)


def residual_sublayer(x, m, j, g_pre, g_post, fn, weight):
    h = rms_norm(x, g_pre) * (1 + m[:, :, 3 * j + 1]) + m[:, :, 3 * j]
    y, aux = fn(h)
    return x + weight * m[:, :, 3 * j + 2] * rms_norm(y, g_post), aux


def trunk_layer(x, cond, mixer, w_mod_l, b_mod_l, pre_l, post_l, gate_l, up_l, down_l):
    m = adaln(cond, w_mod_l, b_mod_l)

    def ffn1(h):
        return swiglu(h, gate_l[0], up_l[0], down_l[0]), None

    def ffn2(h):
        return swiglu(h, gate_l[1], up_l[1], down_l[1]), None

    x, _ = residual_sublayer(x, m, 0, pre_l[0], post_l[0], ffn1, FFN_RESID)
    x, aux = residual_sublayer(x, m, 1, pre_l[1], post_l[1], mixer, 1.0)
    x, _ = residual_sublayer(x, m, 2, pre_l[2], post_l[2], ffn2, FFN_RESID)
    return x, aux


def setup_inputs(seed: int = 0) -> dict:
    key = jax.random.key(seed)
    ks = jax.random.split(key, 24)
    f32 = jnp.float32

    def nrm(k, shape, s=1.0):
        return s * jax.random.normal(k, shape, f32)

    def gain(k, shape):
        return 1.0 + 0.05 * jax.random.normal(k, shape, f32)

    cshape = (DEC_BATCH, DEPTH, PAST_LEN)
    return {
        "x_prompt": nrm(ks[0], (BATCH, SEQ, D_MODEL)),
        "x_sample": nrm(ks[1], (DEC_BATCH, DEC_SEQ, D_MODEL)),
        "cache_a_k": nrm(ks[2], cshape + (A_KV, HEAD_DIM)),
        "cache_a_v": nrm(ks[3], cshape + (A_KV, HEAD_DIM)),
        "cache_b_k": nrm(ks[4], cshape + (B_HEADS, 2 * B_QK_DIM)),
        "cache_b_v": nrm(ks[5], cshape + (B_HEADS, HEAD_DIM)),
        "cache_c_k": nrm(ks[6], cshape + (C_KV, HEAD_DIM)),
        "cache_c_v": nrm(ks[7], cshape + (C_KV, HEAD_DIM)),
        "c": nrm(ks[8], (DEC_BATCH, D_MODEL)),
        "c_ctx": nrm(ks[9], (D_MODEL,)),
        "w_mod": nrm(ks[10], (DEPTH, D_MODEL, 3 * N_SUB * D_MODEL), 0.5 * D_MODEL ** -0.5),
        "b_mod": nrm(ks[11], (DEPTH, 3 * N_SUB * D_MODEL), 0.01),
        "norm_pre": gain(ks[12], (DEPTH, N_SUB, D_MODEL)),
        "norm_post": gain(ks[13], (DEPTH, N_SUB, D_MODEL)),
        "ffn_gate": nrm(ks[14], (DEPTH, 2, D_MODEL, D_FF), D_MODEL ** -0.5),
        "ffn_up": nrm(ks[15], (DEPTH, 2, D_MODEL, D_FF), D_MODEL ** -0.5),
        "ffn_down": nrm(ks[16], (DEPTH, 2, D_FF, D_MODEL), D_FF ** -0.5),
        "w_in": nrm(ks[17], (DEPTH, D_MODEL, IN_WIDTH), D_MODEL ** -0.5),
        "w_out": nrm(ks[18], (DEPTH, MIX_WIDTH, D_MODEL), MIX_WIDTH ** -0.5),
        "a_sink": nrm(ks[19], (DEPTH, A_HEADS)),
        "b_lambda": nrm(ks[20], (DEPTH, 4, B_QK_DIM), 0.1),
        "b_subln": gain(ks[21], (DEPTH, HEAD_DIM)),
        "c_qnorm": gain(ks[22], (DEPTH, HEAD_DIM)),
        "c_knorm": gain(ks[23], (DEPTH, HEAD_DIM)),
    }


def reference(x_prompt, x_sample, cache_a_k, cache_a_v, cache_b_k, cache_b_v, cache_c_k, cache_c_v,
              c, c_ctx, w_mod, b_mod, norm_pre, norm_post, ffn_gate, ffn_up, ffn_down,
              w_in, w_out, a_sink, b_lambda, b_subln, c_qnorm, c_knorm):
    ctx_cond = c_ctx[None, :]
    xp = x_prompt
    ctx_lists = ([], [], [], [], [], [])
    for l in range(DEPTH):
        lam_init = 0.8 - 0.6 * math.exp(-0.3 * l)
        lam = diff_lambda(b_lambda[l], lam_init)

        def mix_ctx(h, l=l, lam=lam, lam_init=lam_init):
            return context_mixer(h, w_in[l], w_out[l], a_sink[l], lam, lam_init,
                                 b_subln[l], c_qnorm[l], c_knorm[l])

        xp, kv = trunk_layer(xp, ctx_cond, mix_ctx, w_mod[l], b_mod[l], norm_pre[l], norm_post[l],
                             ffn_gate[l], ffn_up[l], ffn_down[l])
        for lst, t in zip(ctx_lists, kv):
            lst.append(t)
    y_prompt = xp
    new_a_k = jnp.stack(ctx_lists[0], axis=1)
    new_a_v = jnp.stack(ctx_lists[1], axis=1)
    new_b_k = jnp.stack(ctx_lists[2], axis=1)
    new_b_v = jnp.stack(ctx_lists[3], axis=1)
    new_c_k = jnp.stack(ctx_lists[4], axis=1)
    new_c_v = jnp.stack(ctx_lists[5], axis=1)

    n_lat = x_sample.shape[1]
    rope_hd = axial_rope_tables(n_lat, HEAD_DIM)
    rope_qk = axial_rope_tables(n_lat, B_QK_DIM)
    xs = x_sample
    for l in range(DEPTH):
        lam_init = 0.8 - 0.6 * math.exp(-0.3 * l)
        lam = diff_lambda(b_lambda[l], lam_init)
        ctx_kv = (cache_a_k[:, l], cache_a_v[:, l], cache_b_k[:, l], cache_b_v[:, l],
                  cache_c_k[:, l], cache_c_v[:, l])

        def mix_lat(h, l=l, lam=lam, lam_init=lam_init, ctx_kv=ctx_kv):
            return latent_mixer(h, ctx_kv, rope_hd, rope_qk, w_in[l], w_out[l], a_sink[l], lam, lam_init,
                                b_subln[l], c_qnorm[l], c_knorm[l])

        xs, _ = trunk_layer(xs, c, mix_lat, w_mod[l], b_mod[l], norm_pre[l], norm_post[l],
                            ffn_gate[l], ffn_up[l], ffn_down[l])
    y_sample = xs
    return (y_prompt, y_sample, new_a_k, new_a_v, new_b_k, new_b_v, new_c_k, new_c_v)
```

```cpp
#include <hip/hip_runtime.h>
#include <hip/hip_bf16.h>
#include <cstdio>
#include <cstdint>
#include <cmath>
#include <type_traits>
template <int K> __device__ __forceinline__ float xshfl(float v) { return __builtin_bit_cast(float, __builtin_amdgcn_ds_swizzle(__builtin_bit_cast(int, v), (K << 10) | 0x1f)); }
__device__ __forceinline__ float wave_sum(float v) {
    v += xshfl<1>(v); v += xshfl<2>(v); v += xshfl<4>(v); v += xshfl<8>(v); v += xshfl<16>(v);
    auto rr = __builtin_amdgcn_permlane32_swap(__float_as_uint(v), __float_as_uint(v), false, false);
    return __uint_as_float(rr[0]) + __uint_as_float(rr[1]);
}
__device__ __forceinline__ size_t opq0() { size_t z; asm volatile("s_mov_b64 %0, 0" : "=s"(z)); return z; }
template <class T> __device__ __forceinline__ T* opq(T* p) { return p + opq0(); }
__device__ __forceinline__ int opq_tid() { int t = threadIdx.x; asm volatile("" : "+v"(t)); return t; }

typedef unsigned wt_u4 __attribute__((ext_vector_type(4)));
typedef unsigned wt_u2 __attribute__((ext_vector_type(2)));
typedef float wt_f4 __attribute__((ext_vector_type(4)));
__device__ __forceinline__ void st16_wt(void* p, wt_u4 v) { asm volatile("global_store_dwordx4 %0, %1, off sc1" :: "v"(p), "v"(v) : "memory"); }
__device__ __forceinline__ void st16_wt(void* p, wt_f4 v) { asm volatile("global_store_dwordx4 %0, %1, off sc1" :: "v"(p), "v"(v) : "memory"); }
__device__ __forceinline__ void st8_wt(void* p, wt_u2 v) { asm volatile("global_store_dwordx2 %0, %1, off sc1" :: "v"(p), "v"(v) : "memory"); }
namespace pg8 {
#define PG8_LAS __attribute__((address_space(3)))
typedef unsigned short bf16_t;
typedef short bf16x8 __attribute__((ext_vector_type(8)));
typedef float f32x4 __attribute__((ext_vector_type(4)));
typedef unsigned u32x4 __attribute__((ext_vector_type(4)));
constexpr int BM = 256, BK = 64, HALF = 128, HTB = HALF * BK * 2  , STAGE_BYTES = 8 * HTB, NXCD = 8, WGM = 8;

__host__ __device__ __forceinline__ int lds_byte(int r, int c) { const int st = (r >> 4) * 2 + (c >> 5), rr = r & 15, cc = c & 31, ob = rr * 64 + cc * 2; return st * 1024 + (ob ^ (((ob >> 9) & 1) << 5)); }
__host__ __device__ __forceinline__ void stage_rc(int b, int& R, int& C) { const int st = b / 1024, sb = b % 1024, swz = sb ^ (((sb >> 9) & 1) << 5); R = (st >> 1) * 16 + swz / 64; C = (st & 1) * 32 + (swz % 64) / 2; }
__host__ __device__ __forceinline__ int perm32(int rho) { const int n = rho >> 4, i = rho & 15; return 8 * (i >> 2) + 4 * n + (i & 3); }

struct Unit { int pm, pn; };
struct Gemm { const bf16_t* A; const bf16_t* Bt; int M, N, K; };

struct StaticOrder {
    int nM, nN, nwg, G, c;
    __host__ __device__ void init(int M, int N, int G_, int c_) { nM = M / BM; nN = N / BM; nwg = nM * nN; G = G_; c = c_; }
    __host__ __device__ bool next(int i, Unit& u) const {
        const long L = (long)i * G + c; if (L >= nwg) return false;
        int wgid = (int)L; { const int q = nwg / NXCD, r = nwg % NXCD, xcd = wgid % NXCD, off = wgid / NXCD; wgid = (xcd < r ? xcd * (q + 1) : r * (q + 1) + (xcd - r) * q) + off; }
        const int nig = WGM * nN, gid = wgid / nig, fm = gid * WGM, gsz = (nM - fm) < WGM ? (nM - fm) : WGM;
        u.pm = fm + ((wgid % nig) % gsz); u.pn = (wgid % nig) / gsz; return true;
    }
    __device__ __forceinline__ void a_ready(const Unit&) const {}
    __device__ __forceinline__ void done(const Unit&) const {}
};

__device__ __forceinline__ unsigned cvt_pk_bf16(float lo, float hi) { unsigned r; asm volatile("v_cvt_pk_bf16_f32 %0, %1, %2" : "=v"(r) : "v"(lo), "v"(hi)); return r; }
typedef float f32x2 __attribute__((ext_vector_type(2)));
typedef float f32x2 __attribute__((ext_vector_type(2)));
__device__ __forceinline__ f32x2 swiglu_pk(f32x2 g, f32x2 u) {
    const f32x2 t = g * (-1.4426950408889634f); f32x2 e; e.x = __builtin_amdgcn_exp2f(t.x); e.y = __builtin_amdgcn_exp2f(t.y);
    const f32x2 d = e + 1.0f; f32x2 r; r.x = __builtin_amdgcn_rcpf(d.x); r.y = __builtin_amdgcn_rcpf(d.y);
    return (g * u) * r;
}
struct EpiSwiglu {
    static constexpr bool PERM = true, AFTER_DRAIN = false;
    bf16_t* O; int ldc;
    __device__ __forceinline__ void operator()(const f32x4 (&acc)[2][2][4][2], const Unit& u, int wr, int wc, int fr, int fq) const {
        const int row0 = u.pm * BM + wr * 64 + fr, col0 = u.pn * HALF + wc * 32 + 8 * fq;
#pragma unroll
        for (int ai = 0; ai < 2; ++ai)
#pragma unroll
            for (int m = 0; m < 4; ++m) {
                bf16_t* rowp = O + (size_t)(row0 + ai * HALF + m * 16) * ldc + col0;
                const f32x4 g0 = acc[ai][0][m][0], g1 = acc[ai][0][m][1], u0 = acc[ai][1][m][0], u1 = acc[ai][1][m][1];
                const f32x2 a = swiglu_pk((f32x2){g0[0], g0[1]}, (f32x2){u0[0], u0[1]}), b = swiglu_pk((f32x2){g0[2], g0[3]}, (f32x2){u0[2], u0[3]});
                const f32x2 c = swiglu_pk((f32x2){g1[0], g1[1]}, (f32x2){u1[0], u1[1]}), d = swiglu_pk((f32x2){g1[2], g1[3]}, (f32x2){u1[2], u1[3]});
                u32x4 w; w.x = cvt_pk_bf16(a.x, a.y); w.y = cvt_pk_bf16(b.x, b.y); w.z = cvt_pk_bf16(c.x, c.y); w.w = cvt_pk_bf16(d.x, d.y);
                *(u32x4*)rowp = w;
            }
    }
};
struct EpiY16 {
    static constexpr bool PERM = true, AFTER_DRAIN = false;
    bf16_t* O; int ldc;
    __device__ __forceinline__ void operator()(const f32x4 (&acc)[2][2][4][2], const Unit& u, int wr, int wc, int fr, int fq) const {
        const int row0 = u.pm * BM + wr * 64 + fr, col0 = u.pn * BM + wc * 32 + 8 * fq;
#pragma unroll
        for (int ai = 0; ai < 2; ++ai)
#pragma unroll
            for (int m = 0; m < 4; ++m) {
                bf16_t* rowp = O + (size_t)(row0 + ai * HALF + m * 16) * ldc + col0;
#pragma unroll
                for (int bj = 0; bj < 2; ++bj) { const f32x4 v0 = acc[ai][bj][m][0], v1 = acc[ai][bj][m][1];
                    u32x4 w; w.x = cvt_pk_bf16(v0[0], v0[1]); w.y = cvt_pk_bf16(v0[2], v0[3]); w.z = cvt_pk_bf16(v1[0], v1[1]); w.w = cvt_pk_bf16(v1[2], v1[3]);
                    *(u32x4*)(rowp + bj * HALF) = w; }
            }
    }
};
struct EpiF32 {
    static constexpr bool PERM = false, AFTER_DRAIN = false;
    float* O; int ldc;
    __device__ __forceinline__ void operator()(const f32x4 (&acc)[2][2][4][2], const Unit& u, int wr, int wc, int fr, int fq) const {
        const int row0 = u.pm * BM + wr * 64 + fr, col0 = u.pn * BM + wc * 32 + 4 * fq;
#pragma unroll
        for (int ai = 0; ai < 2; ++ai)
#pragma unroll
            for (int m = 0; m < 4; ++m) {
                float* rowp = O + (size_t)(row0 + ai * HALF + m * 16) * ldc + col0;
#pragma unroll
                for (int bj = 0; bj < 2; ++bj)
#pragma unroll
                    for (int n = 0; n < 2; ++n) *(f32x4*)(rowp + bj * HALF + n * 16) = acc[ai][bj][m][n];
            }
    }
};
struct EpiQKV {
    static constexpr bool PERM = true, AFTER_DRAIN = false;
    bf16_t* P; float* out; int layer; const float* rope; const float* qn; const float* kn; PG8_LAS float* part;
    __device__ __forceinline__ void operator()(const f32x4 (&acc)[2][2][4][2], const Unit& u, int wr, int wc, int fr, int fq) const {
        const int pn = u.pn, pm = u.pm, col0 = pn * BM + wc * 32 + 8 * fq;
        const bool lat = pm >= 16, norm = pn >= 11 && pn <= 14;
        const int rtype = (pn <= 3 || norm) ? 1 : ((pn >= 5 && pn <= 8) ? 2 : 0);
        const int a = (rtype == 2 ? 16 * (wc & 1) : 16 * wc) + 4 * fq;
        float* ob = nullptr; int W = 256, c0 = 0;
        if (!lat) {
            if (pn == 3) ob = out + 16777216; else if (pn == 4) ob = out + 20971520;
            else if (pn == 7) { ob = out + 25165824; W = 512; } else if (pn == 8) { ob = out + 25165824; W = 512; c0 = 256; }
            else if (pn == 9) { ob = out + 33554432; W = 512; } else if (pn == 10) { ob = out + 33554432; W = 512; c0 = 256; }
            else if (pn == 14) ob = out + 41943040; else if (pn == 15) ob = out + 46137344;
        }
        f32x4 g1 = {1.f, 1.f, 1.f, 1.f}, g2 = g1;
        f32x4 csn[2] = {g1, g1};
        if (norm) {
            const float* g = (pn == 14 ? kn : qn) + layer * 128; g1 = *(const f32x4*)(g + a); g2 = *(const f32x4*)(g + 64 + a);
#pragma unroll
            for (int ai = 0; ai < 2; ++ai)
#pragma unroll
                for (int m = 0; m < 4; ++m)
#pragma unroll
                    for (int bj = 0; bj < 2; ++bj) { const f32x4 v0 = acc[ai][bj][m][0], v1 = acc[ai][bj][m][1];
                        float ss = (v0[0] * v0[0] + v0[1] * v0[1]) + (v0[2] * v0[2] + v0[3] * v0[3]) + (v1[0] * v1[0] + v1[1] * v1[1]) + (v1[2] * v1[2] + v1[3] * v1[3]);
                        ss += __builtin_bit_cast(float, __builtin_amdgcn_ds_swizzle(__builtin_bit_cast(int, ss), (16 << 10) | 0x1f));
                        { auto rr = __builtin_amdgcn_permlane32_swap(__float_as_uint(ss), __float_as_uint(ss), false, false); ss = __uint_as_float(rr[0]) + __uint_as_float(rr[1]); }
                        if (fq == 0) part[((ai * HALF + wr * 64 + m * 16 + fr) * 2 + bj) * 4 + wc] = ss; }
            asm volatile("s_waitcnt lgkmcnt(0)" ::: "memory"); __builtin_amdgcn_s_barrier(); asm volatile("" ::: "memory");
        }
#pragma unroll
        for (int ai = 0; ai < 2; ++ai)
#pragma unroll
            for (int m = 0; m < 4; ++m) {
                const int t = wr * 64 + fr + ai * HALF + m * 16;
                bf16_t* rowp = P + (size_t)(pm * BM + t) * 4096 + col0;
                f32x4 cs2[2], sn2[2];
                if ((m & 1) == 0) {
#pragma unroll
                    for (int e2 = 0; e2 < 2; ++e2) { cs2[e2] = (f32x4){1.f, 1.f, 1.f, 1.f}; sn2[e2] = (f32x4){0.f, 0.f, 0.f, 0.f};
                        if (lat && rtype != 0) { const int tok = (pm * BM + t + 16 * e2) & 2047;
                            const float* cp = rtype == 1 ? rope + tok * 64 + a : rope + 262144 + tok * 32 + a;
                            cs2[e2] = *(const f32x4*)cp; sn2[e2] = *(const f32x4*)(cp + (rtype == 1 ? 131072 : 65536)); } }
                    csn[0] = cs2[1]; csn[1] = sn2[1];
                }
                const f32x4 cs = (m & 1) == 0 ? cs2[0] : csn[0], sn = (m & 1) == 0 ? sn2[0] : csn[1];
#pragma unroll
                for (int bj = 0; bj < 2; ++bj) {
                    const f32x4 v0 = acc[ai][bj][m][0], v1 = acc[ai][bj][m][1];
                    if (rtype == 0) {
                        u32x4 w; w.x = cvt_pk_bf16(v0[0], v0[1]); w.y = cvt_pk_bf16(v0[2], v0[3]); w.z = cvt_pk_bf16(v1[0], v1[1]); w.w = cvt_pk_bf16(v1[2], v1[3]);
                        *(u32x4*)(rowp + bj * HALF) = w;
                        if (ob) { float* o = ob + (size_t)((pm * 4 + layer) * 256 + t) * W + c0 + wc * 32 + 8 * fq + bj * HALF; *(f32x4*)o = v0; *(f32x4*)(o + 4) = v1; }
                    } else {
                        f32x4 x1 = {v0[0], v0[2], v1[0], v1[2]}, x2 = {v0[1], v0[3], v1[1], v1[3]};
                        if (norm) { const f32x4 pt = *(const PG8_LAS f32x4*)(part + ((ai * HALF + wr * 64 + m * 16 + fr) * 2 + bj) * 4);
                            const float r = 1.0f / sqrtf(((pt[0] + pt[1]) + (pt[2] + pt[3])) * (1.0f / 128.0f) + 1e-6f); x1 = x1 * r * g1; x2 = x2 * r * g2; }
                        const f32x4 o1 = x1 * cs - x2 * sn, o2 = x2 * cs + x1 * sn;
                        u32x4 w; w.x = cvt_pk_bf16(o1[0], o2[0]); w.y = cvt_pk_bf16(o1[1], o2[1]); w.z = cvt_pk_bf16(o1[2], o2[2]); w.w = cvt_pk_bf16(o1[3], o2[3]);
                        *(u32x4*)(rowp + bj * HALF) = w;
                        if (ob) { float* o = ob + (size_t)((pm * 4 + layer) * 256 + t) * W + c0 + bj * HALF + (rtype == 2 ? (wc >> 1) * 64 : 0) + a;
                            *(f32x4*)o = o1; *(f32x4*)(o + (rtype == 2 ? 32 : 64)) = o2; }
                    }
                }
            }
    }
};
template <class Epi, class Sched, bool ALIGN_EPI = false, bool SP2 = false>
__device__ __forceinline__ void gemm_phase(PG8_LAS unsigned char* lds, const Gemm g, const Sched& S, const Epi& E) {
    int tid_ = threadIdx.x; asm volatile("" : "+v"(tid_));
    const int tid = tid_, wid = __builtin_amdgcn_readfirstlane(tid >> 6), lane = tid & 63, wr = wid >> 2, wc = wid & 3, fr = lane & 15, fq = lane >> 4;
    const int K = g.K, nt = K / BK;
    unsigned voffA[2], voffB[2];
#pragma unroll
    for (int i = 0; i < 2; ++i) { int R, C; stage_rc(tid * 16 + i * 8192, R, C); const int Rb = Epi::PERM ? ((R & ~31) + perm32(R & 31)) : R;
        voffA[i] = (unsigned)(R * K + C) * 2u; voffB[i] = (unsigned)(Rb * K + C) * 2u; }
    const size_t kstep = (size_t)(BK * 2);
    const size_t hstep = (size_t)HALF * K * 2;
    const size_t tstep = 2 * hstep;
    const unsigned ldsw = (unsigned)wid * 1024u;
    const int aoff = lds_byte(wr * 64 + fr, fq * 8), boff = lds_byte(wc * 32 + fr, fq * 8);
#define PG8_SA(b, h) (((b) * 2 + (h)) * HTB)
#define PG8_SB(b, h) ((4 + (b) * 2 + (h)) * HTB)
#define PG8_STAGE(bufoff, gbase, voff) do { _Pragma("unroll") for (int _i = 0; _i < 2; ++_i) \
        __builtin_amdgcn_global_load_lds((const unsigned*)((const char*)(gbase) + (voff)[_i]), (PG8_LAS unsigned*)(lds + (bufoff) + ldsw + _i * 8192), 16, 0, 0); } while (0)
#define PG8_LDA(dst, b, h) do { _Pragma("unroll") for (int m = 0; m < 4; ++m) _Pragma("unroll") for (int k = 0; k < 2; ++k) dst[m][k] = *(const PG8_LAS bf16x8*)(lds + PG8_SA(b, h) + aoff + m * 2048 + k * 1024); } while (0)
#define PG8_LDB(dst, b, h) do { _Pragma("unroll") for (int n = 0; n < 2; ++n) _Pragma("unroll") for (int k = 0; k < 2; ++k) dst[n][k] = *(const PG8_LAS bf16x8*)(lds + PG8_SB(b, h) + boff + n * 2048 + k * 1024); } while (0)
#define PG8_MMA(ai, bj, At, Bt) do { __builtin_amdgcn_s_setprio(1); _Pragma("unroll") for (int m = 0; m < 4; ++m) _Pragma("unroll") for (int n = 0; n < 2; ++n) _Pragma("unroll") for (int k = 0; k < 2; ++k) \
        acc[ai][bj][m][n] = __builtin_amdgcn_mfma_f32_16x16x32_bf16(Bt[n][k], At[m][k], acc[ai][bj][m][n], 0, 0, 0); __builtin_amdgcn_s_setprio(0); } while (0)
#define PG8_WAIT_V(n) asm volatile("s_waitcnt vmcnt(" #n ")" ::: "memory")
#define PG8_WAIT_L(n) asm volatile("s_waitcnt lgkmcnt(" #n ")" ::: "memory")
#define PG8_BAR __builtin_amdgcn_s_barrier()
#define PG8_SCHED __builtin_amdgcn_sched_barrier(0)
    Unit cur, nxt; int ui = 0;
    if (!S.next(0, cur)) return;
    f32x4 acc[2][2][4][2];
#pragma unroll
    for (int a = 0; a < 2; ++a)
#pragma unroll
        for (int b = 0; b < 2; ++b)
#pragma unroll
            for (int m = 0; m < 4; ++m)
#pragma unroll
                for (int n = 0; n < 2; ++n) acc[a][b][m][n] = (f32x4){0.f, 0.f, 0.f, 0.f};
    bf16x8 At[4][2], B0[2][2], B1[2][2];
    const char* cA = (const char*)g.A + (size_t)cur.pm * tstep; const char* cB = (const char*)g.Bt + (size_t)cur.pn * tstep;
    S.a_ready(cur);
    if constexpr (SP2) {
        PG8_STAGE(PG8_SB(0, 0), cB, voffB); PG8_STAGE(PG8_SB(0, 1), cB + hstep, voffB); PG8_STAGE(PG8_SA(0, 0), cA, voffA); PG8_STAGE(PG8_SA(0, 1), cA + hstep, voffA);
        if (wr == 1) PG8_BAR;
        PG8_WAIT_V(2); PG8_BAR;
        PG8_STAGE(PG8_SB(1, 0), cB + kstep, voffB); PG8_STAGE(PG8_SA(1, 0), cA + kstep, voffA); PG8_STAGE(PG8_SB(1, 1), cB + hstep + kstep, voffB);
        PG8_WAIT_V(6); PG8_BAR;
    } else {
        PG8_STAGE(PG8_SB(0, 0), cB, voffB); PG8_STAGE(PG8_SA(0, 0), cA, voffA); PG8_STAGE(PG8_SB(0, 1), cB + hstep, voffB); PG8_STAGE(PG8_SA(0, 1), cA + hstep, voffA);
        if (wr == 1) PG8_BAR;
        PG8_WAIT_V(4); PG8_BAR;
        PG8_STAGE(PG8_SB(1, 0), cB + kstep, voffB); PG8_STAGE(PG8_SA(1, 0), cA + kstep, voffA); PG8_STAGE(PG8_SB(1, 1), cB + hstep + kstep, voffB);
        PG8_WAIT_V(6); PG8_BAR;
    }
    for (;;) {
        const bool has_next = S.next(ui + 1, nxt);
        const char* nA = has_next ? (const char*)g.A + (size_t)nxt.pm * tstep : cA; const char* nB = has_next ? (const char*)g.Bt + (size_t)nxt.pn * tstep : cB;
        for (int t = 0; t < nt; t += 2) {
            const bool last = (t == nt - 2);
            const char* a1 = cA + (size_t)(t + 1) * kstep;
            const char* a2 = last ? nA : cA + (size_t)(t + 2) * kstep; const char* b2 = last ? nB : cB + (size_t)(t + 2) * kstep;
            const char* a3 = a2 + kstep; const char* b3 = b2 + kstep;
            if (last && has_next) S.a_ready(nxt);
            if constexpr (SP2) {
            PG8_LDB(B0, 0, 0); PG8_LDB(B1, 0, 1); PG8_SCHED; PG8_LDA(At, 0, 0); PG8_STAGE(PG8_SA(1, 1), a1 + hstep, voffA);
            PG8_WAIT_V(8); PG8_WAIT_L(0); PG8_BAR; PG8_MMA(0, 0, At, B0); PG8_MMA(0, 1, At, B1); PG8_BAR; PG8_SCHED;
            PG8_LDA(At, 0, 1); PG8_STAGE(PG8_SB(0, 0), b2, voffB); PG8_STAGE(PG8_SB(0, 1), b2 + hstep, voffB); PG8_STAGE(PG8_SA(0, 0), a2, voffA);
            PG8_WAIT_V(8); PG8_WAIT_L(0); PG8_BAR; PG8_MMA(1, 0, At, B0); PG8_MMA(1, 1, At, B1); PG8_BAR; PG8_SCHED;
            PG8_LDB(B0, 1, 0); PG8_LDB(B1, 1, 1); PG8_SCHED; PG8_LDA(At, 1, 0); PG8_STAGE(PG8_SA(0, 1), a2 + hstep, voffA);
            PG8_WAIT_V(8); PG8_WAIT_L(0); PG8_BAR; PG8_MMA(0, 0, At, B0); PG8_MMA(0, 1, At, B1); PG8_BAR; PG8_SCHED;
            PG8_LDA(At, 1, 1); PG8_STAGE(PG8_SB(1, 0), b3, voffB); PG8_STAGE(PG8_SB(1, 1), b3 + hstep, voffB); PG8_STAGE(PG8_SA(1, 0), a3, voffA);
            PG8_WAIT_V(8); PG8_WAIT_L(0); PG8_BAR; PG8_MMA(1, 0, At, B0); PG8_MMA(1, 1, At, B1); PG8_BAR; PG8_SCHED;
            } else {
            PG8_LDB(B0, 0, 0); PG8_SCHED; PG8_LDA(At, 0, 0); PG8_STAGE(PG8_SA(1, 1), a1 + hstep, voffA);
            PG8_WAIT_L(8); PG8_BAR; PG8_WAIT_L(0); PG8_MMA(0, 0, At, B0); PG8_BAR; PG8_SCHED;
            PG8_LDB(B1, 0, 1); PG8_STAGE(PG8_SB(0, 0), b2, voffB);
            PG8_BAR; PG8_WAIT_L(0); PG8_MMA(0, 1, At, B1); PG8_BAR;
            PG8_LDA(At, 0, 1); PG8_STAGE(PG8_SA(0, 0), a2, voffA);
            PG8_BAR; PG8_WAIT_L(0); PG8_MMA(1, 0, At, B0); PG8_BAR; PG8_SCHED;
            PG8_STAGE(PG8_SB(0, 1), b2 + hstep, voffB);
            PG8_WAIT_V(6); PG8_BAR; PG8_MMA(1, 1, At, B1); PG8_BAR;
            PG8_LDB(B0, 1, 0); PG8_SCHED; PG8_LDA(At, 1, 0); PG8_STAGE(PG8_SA(0, 1), a2 + hstep, voffA);
            PG8_WAIT_L(8); PG8_BAR; PG8_WAIT_L(0); PG8_MMA(0, 0, At, B0); PG8_BAR; PG8_SCHED;
            PG8_LDB(B1, 1, 1); PG8_STAGE(PG8_SB(1, 0), b3, voffB);
            PG8_BAR; PG8_WAIT_L(0); PG8_MMA(0, 1, At, B1); PG8_BAR;
            PG8_LDA(At, 1, 1); PG8_STAGE(PG8_SA(1, 0), a3, voffA);
            PG8_BAR; PG8_WAIT_L(0); PG8_MMA(1, 0, At, B0); PG8_BAR; PG8_SCHED;
            PG8_STAGE(PG8_SB(1, 1), b3 + hstep, voffB);
            PG8_WAIT_V(6); PG8_BAR; PG8_MMA(1, 1, At, B1); PG8_BAR;
            }
        }
        if constexpr (ALIGN_EPI) { if (wr == 0) PG8_BAR; }
        if constexpr (!Epi::AFTER_DRAIN) { E(acc, cur, wr, wc, fr, fq); S.done(cur); }
        if (!has_next) break;
#pragma unroll
        for (int a = 0; a < 2; ++a)
#pragma unroll
            for (int b = 0; b < 2; ++b)
#pragma unroll
                for (int m = 0; m < 4; ++m)
#pragma unroll
                    for (int n = 0; n < 2; ++n) acc[a][b][m][n] = (f32x4){0.f, 0.f, 0.f, 0.f};
        cur = nxt; cA = nA; cB = nB; ++ui;
        if constexpr (ALIGN_EPI) { if (wr == 1) PG8_BAR; }
    }
    PG8_WAIT_V(0);
    if constexpr (!ALIGN_EPI) { if (wr == 0) PG8_BAR; }
    PG8_BAR;
    if constexpr (Epi::AFTER_DRAIN) { E.fused(acc, cur, wr, wc, fr, fq, lds, wid, lane); S.done(cur); }
#undef PG8_SA
#undef PG8_SB
#undef PG8_STAGE
#undef PG8_LDA
#undef PG8_LDB
#undef PG8_MMA
#undef PG8_WAIT_V
#undef PG8_WAIT_L
#undef PG8_BAR
#undef PG8_SCHED
}
}
namespace att {
typedef unsigned short bf16;
using bf16x8 = __attribute__((ext_vector_type(8))) short;
using s16x4  = __attribute__((ext_vector_type(4))) short;
using f32x16 = __attribute__((ext_vector_type(16))) float;
using u32x4  = __attribute__((ext_vector_type(4))) unsigned;
constexpr int NW = 8, QBLK = 32, KVBLK = 64;
constexpr int SHM_V = KVBLK * 128 * 2, SHM_K = KVBLK * 128 * 2, SHM_WS = 2 * SHM_V + 2 * SHM_K, SHM_Q = SHM_WS + NW * 64 * 4, SHM_ATTN = SHM_Q + NW * 8192;
constexpr float THR = 8.f;
#ifndef ATT_NQREG
#define ATT_NQREG 2
#endif
constexpr int NQREG = ATT_NQREG;
constexpr float LOG2E = 1.4426950408889634f;
#define KSWZ(row, colB) ((row) * 256 + ((colB) ^ (((row) & 7) << 4)))
#define SBAR() __builtin_amdgcn_sched_barrier(0)
__device__ __forceinline__ int crow(int r, int hi) { return (r & 3) + 8 * (r >> 2) + 4 * hi; }
__device__ __forceinline__ unsigned cvtpk(float lo, float hi) { unsigned r; asm volatile("v_cvt_pk_bf16_f32 %0, %1, %2" : "=v"(r) : "v"(lo), "v"(hi)); return r; }
template <int ND0> struct Sc { static constexpr float SCALE = (ND0 == 8) ? 0.088388347648318440f : 0.125f; };

template <int ND0>
__device__ __forceinline__ void partialSM(f32x16& p0, f32x16& p1, float& m_reg, float& mn, float& alpha) {
  constexpr float SCALE = Sc<ND0>::SCALE, C = SCALE * LOG2E;
  float pmax = p0[0];
#pragma unroll
  for (int r = 1; r < 16; ++r) pmax = fmaxf(pmax, p0[r]);
#pragma unroll
  for (int r = 0; r < 16; ++r) pmax = fmaxf(pmax, p1[r]);
  { auto rr = __builtin_amdgcn_permlane32_swap(__float_as_uint(pmax), __float_as_uint(pmax), false, false);
    pmax = fmaxf(__uint_as_float(rr[0]), __uint_as_float(rr[1])); }
  if (__builtin_expect(__all(pmax - m_reg <= THR / SCALE), 1)) { mn = m_reg; alpha = 1.f; }
  else { mn = fmaxf(m_reg, pmax); alpha = __builtin_amdgcn_exp2f((m_reg - mn) * C); m_reg = mn; }
  float mnC = -mn * C;
#pragma unroll
  for (int r = 0; r < 16; ++r) p0[r] = fmaf(p0[r], C, mnC);
#pragma unroll
  for (int r = 0; r < 16; ++r) p1[r] = fmaf(p1[r], C, mnC);
#pragma unroll
  for (int r = 0; r < 16; ++r) p0[r] = __builtin_amdgcn_exp2f(p0[r]);
}
__device__ __forceinline__ void finishSM(f32x16& p0, f32x16& p1, float alpha, float& l_reg, bf16x8& pa0, bf16x8& pa1, bf16x8& pa2, bf16x8& pa3) {
#pragma unroll
  for (int r = 0; r < 16; ++r) p1[r] = __builtin_amdgcn_exp2f(p1[r]);
  float ps = 0;
#pragma unroll
  for (int r = 0; r < 16; ++r) ps += p0[r];
#pragma unroll
  for (int r = 0; r < 16; ++r) ps += p1[r];
  { auto rr = __builtin_amdgcn_permlane32_swap(__float_as_uint(ps), __float_as_uint(ps), false, false);
    ps = __uint_as_float(rr[0]) + __uint_as_float(rr[1]); }
  l_reg = l_reg * alpha + ps;
#define PK4(P, BASE, OUT) do { unsigned a0 = cvtpk(P[BASE + 0], P[BASE + 1]), a1 = cvtpk(P[BASE + 2], P[BASE + 3]);   \
    unsigned b0 = cvtpk(P[BASE + 4], P[BASE + 5]), b1 = cvtpk(P[BASE + 6], P[BASE + 7]);                              \
    auto r0 = __builtin_amdgcn_permlane32_swap(a0, b0, false, false); auto r1 = __builtin_amdgcn_permlane32_swap(a1, b1, false, false); \
    u32x4 w = {r0[0], r1[0], r0[1], r1[1]}; OUT = *reinterpret_cast<bf16x8*>(&w); } while (0)
  PK4(p0, 0, pa0); PK4(p0, 8, pa1); PK4(p1, 0, pa2); PK4(p1, 8, pa3);
#undef PK4
}
template <int ND0>
__device__ __forceinline__ void qkt(f32x16& p0, f32x16& p1, const bf16* Ks, const char* qpark, const bf16x8* qreg, int r32, int hi, int koffB) {
  p0 = f32x16{}; p1 = f32x16{};
#pragma unroll
  for (int d0 = 0; d0 < ND0; ++d0) { int cb = (d0 * 16 + hi * 8) * 2 + koffB;
    bf16x8 b0 = *reinterpret_cast<const bf16x8*>((const char*)Ks + KSWZ(r32, cb));
    bf16x8 b1 = *reinterpret_cast<const bf16x8*>((const char*)Ks + KSWZ(32 + r32, cb));
    const bf16x8 q = (d0 < NQREG) ? qreg[d0 < NQREG ? d0 : 0] : *reinterpret_cast<const bf16x8*>(qpark + d0 * 1024);
    p0 = __builtin_amdgcn_mfma_f32_32x32x16_bf16(b0, q, p0, 0, 0, 0);
    p1 = __builtin_amdgcn_mfma_f32_32x32x16_bf16(b1, q, p1, 0, 0, 0); }
}
__device__ __forceinline__ void wmask(f32x16& p0, f32x16& p1, int kbase, int qpos, int hi) {
  const int d = kbase + 4 * hi - qpos;
#pragma unroll
  for (int r = 0; r < 16; ++r) { const int dk = d + (r & 3) + 8 * (r >> 2);
    if (dk > 128 || dk < -128) p0[r] = -INFINITY;
    if (dk + 32 > 128 || dk + 32 < -128) p1[r] = -INFINITY; }
}
__device__ __forceinline__ int v_st(int k, int c) { const int kk = (k & ~0xC) | ((k & 4) << 1) | ((k & 8) >> 1); return ((kk >> 3) * 4 + (c >> 5)) * 512 + ((kk & 7) * 32 + (c & 31)) * 2; }
__device__ __forceinline__ int v_rd_base(int lane) { return ((lane & 3) << 3) | (((lane >> 2) & 3) << 6) | (((lane >> 4) & 1) << 5) | (((lane >> 5) & 1) << 8); }
constexpr int v_rd_off(int d0, int ks, int half) { return d0 * 512 + ks * 4096 + half * 2048; }
template <int OFF> __device__ __forceinline__ s16x4 tr_read(int vb) {
  s16x4 r; asm volatile("ds_read_b64_tr_b16 %0, %1 offset:%2" : "=&v"(r) : "v"(vb), "i"(OFF) : "memory"); return r;
}
template <int D0> __device__ __forceinline__ void pv_one(f32x16& od, int vb, bf16x8 pa0, bf16x8 pa1, bf16x8 pa2, bf16x8 pa3) {
  const s16x4 l0 = tr_read<v_rd_off(D0, 0, 0)>(vb), h0 = tr_read<v_rd_off(D0, 0, 1)>(vb), l1 = tr_read<v_rd_off(D0, 1, 0)>(vb), h1 = tr_read<v_rd_off(D0, 1, 1)>(vb);
  const s16x4 l2 = tr_read<v_rd_off(D0, 2, 0)>(vb), h2 = tr_read<v_rd_off(D0, 2, 1)>(vb), l3 = tr_read<v_rd_off(D0, 3, 0)>(vb), h3 = tr_read<v_rd_off(D0, 3, 1)>(vb);
  asm volatile("s_waitcnt lgkmcnt(0)" ::: "memory"); SBAR();
#define PK(L, H) (bf16x8){L[0], L[1], L[2], L[3], H[0], H[1], H[2], H[3]}
  od = __builtin_amdgcn_mfma_f32_32x32x16_bf16(pa0, PK(l0, h0), od, 0, 0, 0);
  od = __builtin_amdgcn_mfma_f32_32x32x16_bf16(pa1, PK(l1, h1), od, 0, 0, 0);
  od = __builtin_amdgcn_mfma_f32_32x32x16_bf16(pa2, PK(l2, h2), od, 0, 0, 0);
  od = __builtin_amdgcn_mfma_f32_32x32x16_bf16(pa3, PK(l3, h3), od, 0, 0, 0);
#undef PK
}
__device__ __forceinline__ void pv_d0(f32x16* o, int vb, bf16x8 pa0, bf16x8 pa1, bf16x8 pa2, bf16x8 pa3) {
  pv_one<0>(o[0], vb, pa0, pa1, pa2, pa3); pv_one<1>(o[1], vb, pa0, pa1, pa2, pa3); pv_one<2>(o[2], vb, pa0, pa1, pa2, pa3); pv_one<3>(o[3], vb, pa0, pa1, pa2, pa3);
}

struct AttnUnit {
  const bf16* Q; int ldq;
  const bf16 *K0, *V0; int ld0, n0;
  const bf16 *K1, *V1; int ld1, n1;
  int koffB;
  int win, qpos0, kpos1;
  int has_sink; float sink;
  int pair;
  bf16* O; int ldo;
  float lam, post; const float* gsub;
};

template <int ND0>
__device__ __forceinline__ void attn_body(const AttnUnit& a, char* lds) {
  constexpr float SCALE = Sc<ND0>::SCALE, C = SCALE * LOG2E;
  int tid_ = threadIdx.x; asm volatile("" : "+v"(tid_));
  const int tid = tid_, wid = __builtin_amdgcn_readfirstlane(tid >> 6), lane = tid & 63, r32 = lane & 31, hi = lane >> 5;
  const int half = (ND0 == 4 && a.pair) ? (wid >> 2) : 0, wrow = (ND0 == 4 && a.pair) ? (wid & 3) : wid;
  const int koffB = a.koffB + half * 128;
  bf16* V_lds = (bf16*)lds; bf16* K_lds = (bf16*)(lds + 2 * SHM_V);
  float* ws = (float*)(lds + SHM_WS) + wid * 64; float* li_l = ws; float* al_l = ws + 32;
  float m_reg = -1e30f, l_reg = 0; f32x16 o[4] = {};
  char* qpark = lds + SHM_Q + wid * 8192 + lane * 16;
  __syncthreads();
  const bf16* Qw = a.Q + (size_t)(wrow * QBLK + r32) * a.ldq + hi * 8 + half * 64;
#pragma unroll
  for (int d0 = 0; d0 < ND0; ++d0) *reinterpret_cast<bf16x8*>(qpark + d0 * 1024) = *reinterpret_cast<const bf16x8*>(Qw + d0 * 16);
  bf16x8 qreg[NQREG];
#pragma unroll
  for (int d0 = 0; d0 < NQREG; ++d0) qreg[d0] = *reinterpret_cast<const bf16x8*>(Qw + d0 * 16);
  const int sr = tid >> 4, sc = (tid & 15) * 8, vst0 = v_st(sr, sc), vst1 = v_st(32 + sr, sc);
  const int vb0 = (int)(uintptr_t)V_lds + v_rd_base(lane);
  const int n0 = a.n0, NT = a.n0 + a.n1;
  const int qpos = a.qpos0 + wid * QBLK + r32, qw0 = a.qpos0 + wid * QBLK;
  struct { bf16x8 vs0, vs1, ks0, ks1; } sr_[2];
#define SLOAD(i, jt) do { const int jt_ = (jt); const bool s0_ = jt_ < n0; const int ld_ = s0_ ? a.ld0 : a.ld1; \
    const bf16* kp_ = s0_ ? a.K0 + (size_t)jt_ * KVBLK * a.ld0 : a.K1 + (size_t)(jt_ - n0) * KVBLK * a.ld1;   \
    const bf16* vp_ = s0_ ? a.V0 + (size_t)jt_ * KVBLK * a.ld0 : a.V1 + (size_t)(jt_ - n0) * KVBLK * a.ld1;   \
    sr_[i].vs0 = *reinterpret_cast<const bf16x8*>(vp_ + (size_t)sr * ld_ + sc); sr_[i].vs1 = *reinterpret_cast<const bf16x8*>(vp_ + (size_t)(32 + sr) * ld_ + sc); \
    sr_[i].ks0 = *reinterpret_cast<const bf16x8*>(kp_ + (size_t)sr * ld_ + sc); sr_[i].ks1 = *reinterpret_cast<const bf16x8*>(kp_ + (size_t)(32 + sr) * ld_ + sc); } while (0)
#define SWRITE(b, i) do { *(bf16x8*)((char*)V_lds + (b) * SHM_V + vst0) = sr_[i].vs0;          \
    *(bf16x8*)((char*)V_lds + (b) * SHM_V + vst1) = sr_[i].vs1; int kc = sc * 2;               \
    *(bf16x8*)((char*)K_lds + (b) * SHM_K + KSWZ(sr, kc)) = sr_[i].ks0;                       \
    *(bf16x8*)((char*)K_lds + (b) * SHM_K + KSWZ(32 + sr, kc)) = sr_[i].ks1; } while (0)
#define SWAIT() asm volatile("s_waitcnt vmcnt(4)" ::: "memory")
#define RESC(al) do { if (__any((al) < 1.f)) { if (hi == 0) al_l[r32] = (al); asm volatile("s_waitcnt lgkmcnt(0)" ::: "memory"); \
    _Pragma("unroll") for (int d = 0; d < 4; ++d) _Pragma("unroll") for (int r = 0; r < 16; ++r) o[d][r] *= al_l[crow(r, hi)]; } } while (0)
#define WMASK(P0, P1, jt) do { if (a.win) { const int jt_ = (jt); if (jt_ >= n0) { const int kb_ = a.kpos1 + (jt_ - n0) * KVBLK; \
    if (kb_ + 63 - qw0 > 128 || qw0 + 31 - kb_ > 128) wmask(P0, P1, kb_, qpos, hi); } } } while (0)
  f32x16 pA0, pA1, pB0, pB1; float mnA, mnB, alA, alB; bf16x8 pa0, pa1, pa2, pa3;
  constexpr int SE = 0, SO = 1;
  SLOAD(SE, 0); asm volatile("s_waitcnt vmcnt(0)" ::: "memory"); SWRITE(0, SE); __syncthreads();
  qkt<ND0>(pA0, pA1, K_lds, qpark, qreg, r32, hi, koffB); WMASK(pA0, pA1, 0); partialSM<ND0>(pA0, pA1, m_reg, mnA, alA);
  SLOAD(SO, 1); if (2 < NT) SLOAD(SE, 2);
  SWAIT(); SWRITE(1, SO); __syncthreads();
  for (int j = 1; j + 1 < NT; j += 2) {
    SBAR(); qkt<ND0>(pB0, pB1, (bf16*)((char*)K_lds + SHM_K), qpark, qreg, r32, hi, koffB);
    finishSM(pA0, pA1, alA, l_reg, pa0, pa1, pa2, pa3); SBAR();
    SLOAD(SO, j + 2); SBAR();
    pv_d0(o, vb0, pa0, pa1, pa2, pa3); WMASK(pB0, pB1, j); partialSM<ND0>(pB0, pB1, m_reg, mnB, alB);
    __syncthreads(); SWAIT(); SWRITE(0, SE);
    RESC(alB); __syncthreads();
    SBAR(); qkt<ND0>(pA0, pA1, K_lds, qpark, qreg, r32, hi, koffB);
    finishSM(pB0, pB1, alB, l_reg, pa0, pa1, pa2, pa3); SBAR();
    if (j + 3 < NT) SLOAD(SE, j + 3); SBAR();
    pv_d0(o, vb0 + (int)SHM_V, pa0, pa1, pa2, pa3); WMASK(pA0, pA1, j + 1); partialSM<ND0>(pA0, pA1, m_reg, mnA, alA);
    __syncthreads(); SWAIT(); SWRITE(1, SO);
    RESC(alA); __syncthreads();
  }
  SBAR(); qkt<ND0>(pB0, pB1, (bf16*)((char*)K_lds + SHM_K), qpark, qreg, r32, hi, koffB);
  finishSM(pA0, pA1, alA, l_reg, pa0, pa1, pa2, pa3); SBAR();
  pv_d0(o, vb0, pa0, pa1, pa2, pa3); WMASK(pB0, pB1, NT - 1); partialSM<ND0>(pB0, pB1, m_reg, mnB, alB);
  __syncthreads(); RESC(alB);
  finishSM(pB0, pB1, alB, l_reg, pa0, pa1, pa2, pa3); SBAR();
  pv_d0(o, vb0 + (int)SHM_V, pa0, pa1, pa2, pa3);
  float l_tot = l_reg;
  if (a.has_sink) l_tot += __builtin_amdgcn_exp2f(a.sink * LOG2E - m_reg * C);
  if (hi == 0) li_l[r32] = l_tot; asm volatile("s_waitcnt lgkmcnt(0)" ::: "memory");
  float rli[16];
#pragma unroll
  for (int r = 0; r < 16; ++r) rli[r] = __builtin_amdgcn_rcpf(li_l[crow(r, hi)]);
  if (!(ND0 == 4 && a.pair)) {
    bf16* Ow = a.O + (size_t)(wid * QBLK) * a.ldo;
#pragma unroll
    for (int r = 0; r < 16; ++r) { const int orow = crow(r, hi);
#pragma unroll
      for (int d0 = 0; d0 < 4; ++d0) Ow[(size_t)orow * a.ldo + d0 * 32 + r32] = (bf16)(cvtpk(o[d0][r] * rli[r], 0.f) & 0xffffu); }
  } else {
    float* X = (float*)lds + (size_t)wrow * 4096 + lane;
    __syncthreads();
    if (half == 1) {
#pragma unroll
      for (int r = 0; r < 16; ++r)
#pragma unroll
        for (int d0 = 0; d0 < 4; ++d0) X[(r * 4 + d0) * 64] = o[d0][r] * rli[r];
    }
    __syncthreads();
    if (half == 0) {
      bf16* Ow = a.O + (size_t)(wrow * QBLK) * a.ldo;
      float gs[4];
#pragma unroll
      for (int d0 = 0; d0 < 4; ++d0) gs[d0] = a.gsub[d0 * 32 + r32] * a.post;
#pragma unroll
      for (int r = 0; r < 16; ++r) { const int orow = crow(r, hi); float ss = 0.f;
#pragma unroll
        for (int d0 = 0; d0 < 4; ++d0) { const float v = o[d0][r] * rli[r] - a.lam * X[(r * 4 + d0) * 64]; o[d0][r] = v; ss += v * v; }
        ss += xshfl<1>(ss); ss += xshfl<2>(ss); ss += xshfl<4>(ss); ss += xshfl<8>(ss); ss += xshfl<16>(ss);
        const float rn = 1.0f / sqrtf(ss * (1.0f / 128.0f) + 1e-6f);
#pragma unroll
        for (int d0 = 0; d0 < 4; ++d0) Ow[(size_t)orow * a.ldo + d0 * 32 + r32] = (bf16)(cvtpk(o[d0][r] * rn * gs[d0], 0.f) & 0xffffu); }
    }
  }
#undef SLOAD
#undef SWRITE
#undef SWAIT
#undef RESC
#undef WMASK
}
#undef KSWZ
#undef SBAR
}
constexpr int D = 2048, FF = 5632, NIN = 4096, DEPTH = 4, M_CTX = 4096, M_LAT = 4096, M = M_CTX + M_LAT;
constexpr int NWAVES = 8;
constexpr float EPS = 1e-6f;
constexpr size_t OFF_AK = 16777216, OFF_AV = 20971520, OFF_BK = 25165824, OFF_BV = 33554432, OFF_CK = 41943040, OFF_CV = 46137344, OUT_TOTAL = 50331648;
constexpr size_t MiB = 1u << 20;
constexpr size_t WS_CTL = 0, CTL_ZERO_BYTES = 1 * MiB;
constexpr size_t WS_MOD = 1 * MiB;
constexpr size_t WS_ROPE = 2 * MiB;
constexpr size_t WS_CACHE = 4 * MiB;
constexpr size_t WS_WGU = 20 * MiB;
constexpr size_t WS_WD = WS_WGU + 8 * 44 * MiB;
constexpr size_t WS_WIN = WS_WD + 8 * 22 * MiB;
constexpr size_t WS_WOUT = WS_WIN + 4 * 16 * MiB;
constexpr size_t WS_H = WS_WOUT + 4 * 8 * MiB;
constexpr size_t WS_ACT = WS_H + 32 * MiB;
constexpr size_t WS_Y = WS_ACT + 88 * MiB;
constexpr size_t WS_P = WS_Y + 64 * MiB;
constexpr size_t WS_O = WS_P + 64 * MiB;
constexpr size_t WS_XB = WS_O + 32 * MiB;
constexpr size_t WS_END = WS_XB + 32 * MiB;
constexpr int CW_TMO = 0, CW_BAR = 4096, CW_Q = 16384;
constexpr int RING_OFF = 0, RING_BYTES = 135168, LDSCTL_OFF = RING_BYTES, MISC_OFF = LDSCTL_OFF + 320, NORM_OFF = LDSCTL_OFF + 2048  , LDS_BYTES = 147456;
static_assert(NORM_OFF + 8192 <= LDS_BYTES, "LDS map");

#define GAS __attribute__((address_space(1)))
#define LAS __attribute__((address_space(3)))
typedef unsigned short bf16;
typedef unsigned v4u __attribute__((ext_vector_type(4)));
typedef unsigned v2u __attribute__((ext_vector_type(2)));
typedef float f32x4 __attribute__((ext_vector_type(4)));
typedef GAS unsigned gu32;
#define RLX_AGENT __ATOMIC_RELAXED, __HIP_MEMORY_SCOPE_AGENT
__device__ __forceinline__ unsigned f2bf(float f) { unsigned u = __builtin_bit_cast(unsigned, f); return (u + 0x7fffu + ((u >> 16) & 1u)) >> 16; }
__device__ __forceinline__ unsigned pk2(float lo, float hi) { return f2bf(lo) | (f2bf(hi) << 16); }
__device__ __forceinline__ float bflo(unsigned w) { return __builtin_bit_cast(float, w << 16); }
__device__ __forceinline__ float bfhi(unsigned w) { return __builtin_bit_cast(float, w & 0xffff0000u); }
#define XB_TMO      128
#define XB_XCNT(j)  (256  + 64 * (j))
#define XB_XSUB(j)  (1280 + 64 * (j))
#define XB_XGEN(j)  (2304 + 64 * (j))
#define XB_TOP      3328
#define XB_TOPGEN   3392
#define XCD_BAR_WORDS 3456
#define XB_SPIN_CAP (1u << 18)

__device__ __forceinline__ unsigned xb_ld(unsigned* p)              { return __hip_atomic_load(p, __ATOMIC_RELAXED, __HIP_MEMORY_SCOPE_AGENT); }
__device__ __forceinline__ unsigned xb_add(unsigned* p, unsigned v) { return __hip_atomic_fetch_add(p, v, __ATOMIC_RELAXED, __HIP_MEMORY_SCOPE_AGENT); }
__device__ __forceinline__ unsigned xb_xcc_id() { return (unsigned)__builtin_amdgcn_s_getreg((3 << 11) | 20) & 0xFu; }
#define XB_SPIN(cond, bar) do { unsigned _sp = 0; while (cond) { __builtin_amdgcn_s_sleep(1); \
    if ((++_sp & 255u) == 0u) { if (xb_ld(&(bar)[XB_TMO])) break; if (_sp > XB_SPIN_CAP) { atomicAdd(&(bar)[XB_TMO], 1u); break; } } } } while (0)

struct XcdBarrier {
    unsigned* bar; unsigned x;
    volatile LAS unsigned* st;
};

__device__ __forceinline__ XcdBarrier xcd_barrier_post(unsigned* bar, volatile LAS unsigned* st) {
    XcdBarrier b; b.bar = bar; b.x = xb_xcc_id(); b.st = st;
    if (threadIdx.x == 0) (void)xb_add(&bar[XB_XCNT(b.x)], 1u);
    return b;
}
__device__ __forceinline__ void xcd_barrier_complete(unsigned* bar, unsigned x, unsigned& nloc, unsigned& nx) {
    const unsigned G = gridDim.x * gridDim.y * gridDim.z;
    unsigned sum, cnt, mine, sp = 0u;
    for (;;) {
        sum = 0u; cnt = 0u; mine = 0u;
#pragma unroll
        for (unsigned j = 0; j < 16; ++j) { const unsigned c = xb_ld(&bar[XB_XCNT(j)]); sum += c; cnt += (c > 0u) ? 1u : 0u; mine = (j == x) ? c : mine; }
        if (sum == G) break;
        __builtin_amdgcn_s_sleep(1);
        if ((++sp & 255u) == 0u) { if (xb_ld(&bar[XB_TMO])) break; if (sp > XB_SPIN_CAP) { atomicAdd(&bar[XB_TMO], 1u); break; } }
    }
    nloc = mine > 0u ? mine : 1u; nx = cnt > 0u ? cnt : 1u;
}

__device__ __forceinline__ void xcd_barrier(const XcdBarrier& b) {
    asm volatile("s_waitcnt vmcnt(0)" ::: "memory");
    __syncthreads();
    if (threadIdx.x == 0) {
        unsigned* bar = b.bar; unsigned bx = b.x; asm volatile("" : "+s"(bar), "+s"(bx));
        __builtin_amdgcn_s_waitcnt(0);
        unsigned nloc = b.st[0], nx = b.st[1];
        if (nloc == 0u) { xcd_barrier_complete(bar, bx, nloc, nx); b.st[0] = nloc; b.st[1] = nx; }
        const unsigned old = xb_add(&bar[XB_XSUB(bx)], 1u);
        const unsigned gen = old / nloc;
        if (old + 1u == (gen + 1u) * nloc) {
            __builtin_amdgcn_fence(__ATOMIC_RELEASE, "agent");
            asm volatile("s_waitcnt vmcnt(0)" ::: "memory");
            const unsigned og = xb_add(&bar[XB_TOP], 1u);
            const unsigned tg = og / nx;
            if (og + 1u == (tg + 1u) * nx) xb_add(&bar[XB_TOPGEN], 1u);
            else XB_SPIN(xb_ld(&bar[XB_TOPGEN]) == tg, bar);
            __builtin_amdgcn_fence(__ATOMIC_ACQUIRE, "agent");
            xb_add(&bar[XB_XGEN(bx)], 1u);
            asm volatile("s_waitcnt vmcnt(0)" ::: "memory");
        } else {
            XB_SPIN(xb_ld(&bar[XB_XGEN(bx)]) == gen, bar);
            __builtin_amdgcn_fence(__ATOMIC_ACQUIRE, "agent");
            asm volatile("s_waitcnt vmcnt(0)" ::: "memory");
        }
    }
    __syncthreads();
}
struct Args { const float* in[24]; float* out; unsigned char* ws; int ph_lo, ph_hi; };
#define PHASE_IDS() const int tid = opq_tid(), lane = tid & 63, wave = __builtin_amdgcn_readfirstlane(tid >> 6), G = (int)gridDim.x, gw = (int)blockIdx.x * NWAVES + wave, NGW = G * NWAVES; (void)lane; (void)gw; (void)NGW; (void)G
enum { I_XP = 0, I_XS, I_CAK, I_CAV, I_CBK, I_CBV, I_CCK, I_CCV, I_C, I_CCTX, I_WMOD, I_BMOD, I_NPRE, I_NPOST, I_FG, I_FU, I_FD, I_WIN, I_WOUT, I_SINK, I_LAM, I_SUBLN, I_QN, I_KN };

__device__ __forceinline__ int cond_of_row(int m) { return m < M_CTX ? 0 : 1 + ((m - M_CTX) >> 11); }
__device__ __forceinline__ const float* mod_vec(const Args& A, int l, int cond, int k) { return (const float*)(A.ws + WS_MOD) + ((size_t)(l * 3 + cond) * 9 + k) * D; }

__device__ __forceinline__ void tr_item(const float* W, int N, int K, int k0, int n0, bf16* WT, size_t drow0, int lane) {
    const int c = lane & 7, nn = lane >> 3;
    const float* src = W + (size_t)(k0 + 8 * c) * N + n0 + 4 * nn;
    f32x4 v[8];
#pragma unroll
    for (int i = 0; i < 8; ++i) v[i] = *(const f32x4*)(src + (size_t)i * N);
#pragma unroll
    for (int j = 0; j < 4; ++j) {
        v4u w; w.x = pk2(v[0][j], v[1][j]); w.y = pk2(v[2][j], v[3][j]); w.z = pk2(v[4][j], v[5][j]); w.w = pk2(v[6][j], v[7][j]);
        *(v4u*)(WT + (drow0 + 4 * nn + j) * (size_t)K + k0 + 8 * c) = w;
    }
}

constexpr int PER_L = 2 * 3 * 5632 + 4096 + 2048;
#ifndef CONV_TAIL
#define CONV_TAIL 6144
#endif
constexpr int CONV_TAIL_X = CONV_TAIL;
struct TrJob { const float* src; bf16* dst; int N, K, rs; };
__device__ __forceinline__ TrJob tr_decode(const Args& A, int l, int r, int lane) {
    const float* W; bf16* WT; int N, K, k0, n0, rs = 1; size_t drow0;
    if (r < 33792) { const int s = r / 16896, r2 = r % 16896, which = r2 / 5632, r3 = r2 % 5632;
        if (which < 2) { const int kb = r3 / 176, nb = r3 % 176; n0 = 32 * nb; k0 = 64 * kb; N = FF; K = D;
            W = A.in[which == 0 ? I_FG : I_FU] + (size_t)(l * 2 + s) * D * FF; WT = (bf16*)(A.ws + WS_WGU) + (size_t)(l * 2 + s) * 11264 * D;
            drow0 = (size_t)(n0 >> 7) * 256 + which * 128 + (n0 & 127);
        } else { const int kb = r3 / 64, nb = r3 % 64; n0 = 32 * nb; k0 = 64 * kb; N = D; K = FF;
            W = A.in[I_FD] + (size_t)(l * 2 + s) * FF * D; WT = (bf16*)(A.ws + WS_WD) + (size_t)(l * 2 + s) * D * FF; drow0 = (size_t)n0; }
    } else { r -= 33792;
        if (r < 4096) { const int kb = r / 128, nb = r % 128; n0 = 32 * nb; k0 = 64 * kb; N = NIN; K = D; W = A.in[I_WIN] + (size_t)l * D * NIN; WT = (bf16*)(A.ws + WS_WIN) + (size_t)l * NIN * D; drow0 = (size_t)n0;
            const bool g128 = n0 < 1024 || (n0 >= 2816 && n0 < 3840), g64 = n0 >= 1280 && n0 < 2304;
            if (g128) { const int i0 = n0 & 127; drow0 = (size_t)(n0 - i0) + 2 * (i0 & 63) + (i0 >> 6); rs = 2; }
            else if (g64) { const int i0 = n0 & 63; drow0 = (size_t)(n0 - i0) + 2 * (i0 & 31) + (i0 >> 5); rs = 2; }
        } else { r -= 4096; const int kb = r / 64, nb = r % 64; n0 = 32 * nb; k0 = 64 * kb; N = D; K = D; W = A.in[I_WOUT] + (size_t)l * D * D; WT = (bf16*)(A.ws + WS_WOUT) + (size_t)l * D * D; drow0 = (size_t)n0; }
    }
    const int c = lane & 7, nn = lane >> 3;
    TrJob j; j.src = W + (size_t)(k0 + 8 * c) * N + n0 + 4 * nn; j.dst = WT + (drow0 + (size_t)(4 * nn) * rs) * (size_t)K + k0 + 8 * c; j.N = N; j.K = K; j.rs = rs; return j;
}
__device__ __forceinline__ void convert_items(const Args& A, int l, int lo, int hi, int w, int nw, int lane) {
    int r = lo + w; if (r >= hi) return;
    TrJob j = tr_decode(A, l, r, lane); f32x4 v[8];
#pragma unroll
    for (int i = 0; i < 8; ++i) v[i] = __builtin_nontemporal_load((const f32x4*)(j.src + (size_t)i * j.N));
    for (;;) {
        const int rn = r + nw; const bool more = rn < hi;
        TrJob jn = j; f32x4 vn[8];
        if (more) { jn = tr_decode(A, l, rn, lane);
#pragma unroll
            for (int i = 0; i < 8; ++i) vn[i] = __builtin_nontemporal_load((const f32x4*)(jn.src + (size_t)i * jn.N)); }
#pragma unroll
        for (int q = 0; q < 4; ++q) { v4u o; o.x = pk2(v[0][q], v[1][q]); o.y = pk2(v[2][q], v[3][q]); o.z = pk2(v[4][q], v[5][q]); o.w = pk2(v[6][q], v[7][q]);
            *(v4u*)(j.dst + (size_t)(q * j.rs) * j.K) = o; }
        if (!more) break;
        r = rn; j = jn;
#pragma unroll
        for (int i = 0; i < 8; ++i) v[i] = vn[i];
    }
}
__device__ __forceinline__ void p0a(const Args& A_, LAS unsigned char* lds) {
    PHASE_IDS(); Args A = A_; A.ws = opq(A_.ws);
    {
        LAS float* sil = (LAS float*)lds; LAS float* red = (LAS float*)(lds + 24576);
        for (int i = tid; i < 3 * D; i += NWAVES * 64) { const int cc = i / D, k = i % D; const float x = cc == 0 ? A.in[I_CCTX][k] : A.in[I_C][(cc - 1) * D + k]; sil[i] = x / (1.0f + expf(-x)); }
        __syncthreads();
        const int kc = tid >> 5, c4 = tid & 31;
        for (int task = blockIdx.x; task < DEPTH * 144; task += G) {
            const int l = task / 144, cb = task % 144;
            const float* w = A.in[I_WMOD] + ((size_t)l * D + kc * 128) * 18432 + cb * 128 + c4 * 4;
            f32x4 a0 = {0.f, 0.f, 0.f, 0.f}, a1 = a0, a2 = a0;
            for (int kk = 0; kk < 128; kk += 8) {
                f32x4 wv[8];
#pragma unroll
                for (int i = 0; i < 8; ++i) wv[i] = *(const f32x4*)(w + (size_t)(kk + i) * 18432);
#pragma unroll
                for (int i = 0; i < 8; ++i) { const int k = kc * 128 + kk + i; a0 += wv[i] * sil[k]; a1 += wv[i] * sil[D + k]; a2 += wv[i] * sil[2 * D + k]; }
            }
            LAS float* rp = red + (kc * 32 + c4) * 12;
#pragma unroll
            for (int i = 0; i < 4; ++i) { rp[i] = a0[i]; rp[4 + i] = a1[i]; rp[8 + i] = a2[i]; }
            __syncthreads();
            if (tid < 384) { const int cc = tid >> 7, col = tid & 127; float s = 0.f;
#pragma unroll
                for (int q = 0; q < 16; ++q) s += red[(q * 32 + (col >> 2)) * 12 + cc * 4 + (col & 3)];
                ((float*)(A.ws + WS_MOD))[(size_t)(l * 3 + cc) * 18432 + cb * 128 + col] = s + A.in[I_BMOD][l * 18432 + cb * 128 + col]; }
            __syncthreads();
        }
    }
    convert_items(A, 0, 0, 11264, gw, NGW, lane);
    const int gt = blockIdx.x * (NWAVES * 64) + tid, NGT = G * NWAVES * 64;
    for (int i = gt; i < DEPTH * 2 * 512 * 256; i += NGT) {
        const int col = (i & 255) * 8, pos = (i >> 8) & 511, b = (i >> 17) & 1, l = i >> 18;
        const size_t rb = (size_t)(b * DEPTH + l) * 512 + pos;
        const float* src;
        if (col < 256) src = A.in[I_CAK] + rb * 256 + col; else if (col < 512) src = A.in[I_CAV] + rb * 256 + (col - 256);
        else if (col < 1024) src = A.in[I_CBK] + rb * 512 + (col - 512); else if (col < 1536) src = A.in[I_CBV] + rb * 512 + (col - 1024);
        else if (col < 1792) src = A.in[I_CCK] + rb * 256 + (col - 1536); else src = A.in[I_CCV] + rb * 256 + (col - 1792);
        const int grp = (col < 256 || (col >= 1536 && col < 1792)) ? 128 : ((col >= 512 && col < 1024) ? 64 : 0);
        f32x4 x0, x1;
        if (grp == 0) { x0 = *(const f32x4*)src; x1 = *(const f32x4*)(src + 4); }
        else { const int pg = col & (grp - 1); const float* sg = src - pg + (pg >> 1);
            const f32x4 lo = *(const f32x4*)sg, hi = *(const f32x4*)(sg + (grp >> 1));
            x0 = (f32x4){lo[0], hi[0], lo[1], hi[1]}; x1 = (f32x4){lo[2], hi[2], lo[3], hi[3]}; }
        v4u w; w.x = pk2(x0[0], x0[1]); w.y = pk2(x0[2], x0[3]); w.z = pk2(x1[0], x1[1]); w.w = pk2(x1[2], x1[3]);
        *(v4u*)((bf16*)(A.ws + WS_CACHE) + ((size_t)(l * 2 + b) * 512 + pos) * 2048 + col) = w;
    }
    {
        float* rp = (float*)(A.ws + WS_ROPE);
        for (int i = gt; i < 2048 * 96; i += NGT) {
            const int t = i / 96, a = i % 96; const float row = (float)(t >> 6), col = (float)(t & 63);
            if (a < 64) { const int f = a & 31; const float inv = powf(10000.0f, -(float)f / 32.0f), ang = (a < 32 ? row : col) * inv;
                rp[t * 64 + a] = cosf(ang); rp[131072 + t * 64 + a] = sinf(ang);
            } else { const int a2 = a - 64, f = a2 & 15; const float inv = powf(10000.0f, -(float)f / 16.0f), ang = (a2 < 16 ? row : col) * inv;
                rp[262144 + t * 32 + a2] = cosf(ang); rp[262144 + 65536 + t * 32 + a2] = sinf(ang); }
        }
    }
}

__device__ __forceinline__ void h_row(const f32x4 (&x)[8], const float* gpre, const float* shift, const float* scale, bf16* hrow, int lane) {
    float ss = 0.f;
#pragma unroll
    for (int j = 0; j < 8; ++j) ss += (x[j][0] * x[j][0] + x[j][1] * x[j][1]) + (x[j][2] * x[j][2] + x[j][3] * x[j][3]);
    const float r = 1.0f / sqrtf(wave_sum(ss) * (1.0f / D) + EPS);
#pragma unroll
    for (int j = 0; j < 8; ++j) { const int o = 256 * j + 4 * lane;
        const f32x4 g = *(const f32x4*)(gpre + o), sh = *(const f32x4*)(shift + o), sc = *(const f32x4*)(scale + o);
        const f32x4 h = (x[j] * r) * g * (sc + 1.0f) + sh;
        v2u w; w.x = pk2(h[0], h[1]); w.y = pk2(h[2], h[3]); *(v2u*)(hrow + o) = w; }
}
__device__ __forceinline__ void t0_phase(const Args& A_) {
    PHASE_IDS(); Args A = A_; A.ws = opq(A_.ws); A.out = opq(A_.out);
    for (int m = gw; m < M; m += NGW) {
        const float* src = m < M_CTX ? A.in[I_XP] + (size_t)m * D : A.in[I_XS] + (size_t)(m - M_CTX) * D;
        f32x4 x[8];
#pragma unroll
        for (int j = 0; j < 8; ++j) x[j] = *(const f32x4*)(src + 256 * j + 4 * lane);
        const int cd = cond_of_row(m);
        h_row(x, A.in[I_NPRE], mod_vec(A, 0, cd, 0), mod_vec(A, 0, cd, 1), (bf16*)(A.ws + WS_H) + (size_t)m * D, lane);
    }
}
template <bool XIN_F32, bool XOUT_F32>
__device__ __forceinline__ void t1_body(const Args& A, int l, int j, LAS unsigned char* lds, int tid, int lane, int wave, int G) {
    const float wgt = (j == 1) ? 1.0f : 0.5f;
    const int nl = (j == 2) ? l + 1 : l, nj = (j == 2) ? 0 : j + 1; const bool has_next = nl < DEPTH;
    const float* gpost = A.in[I_NPOST] + (size_t)(l * 3 + j) * D;
    const float* gpre = A.in[I_NPRE] + (size_t)((has_next ? nl : 0) * 3 + nj) * D;
    LAS f32x4* V0 = (LAS f32x4*)lds; LAS f32x4* V1 = (LAS f32x4*)(lds + 8192); LAS f32x4* V2 = (LAS f32x4*)(lds + 16384);
    const bf16* Yb = (const bf16*)(A.ws + WS_Y); bf16* Hb = (bf16*)(A.ws + WS_H); bf16* Xb = (bf16*)(A.ws + WS_XB);
    typedef typename std::conditional<XIN_F32, f32x4, v2u>::type xraw_t;
    for (int blk = blockIdx.x; blk < M / 32; blk += G) {
        const int mb = blk * 32, cd = cond_of_row(mb);
        {
            const int o = 4 * tid;
            const f32x4 g = *(const f32x4*)(mod_vec(A, l, cd, 3 * j + 2) + o), gp = *(const f32x4*)(gpost + o);
            V0[tid] = (g * wgt) * gp;
            if (has_next) { const f32x4 ge = *(const f32x4*)(gpre + o), sc = *(const f32x4*)(mod_vec(A, nl, cd, 3 * nj + 1) + o), sh = *(const f32x4*)(mod_vec(A, nl, cd, 3 * nj) + o);
                V1[tid] = ge * (sc + 1.0f); V2[tid] = sh; }
        }
        __syncthreads();
        const int m0 = mb + 4 * wave;
        const float* Xsrc = mb < M_CTX ? A.in[I_XP] : A.in[I_XS] - (size_t)M_CTX * D;
        v2u ya[8], yb[8]; xraw_t xa[8], xb[8];
#define T1_LOAD(Y, X, m) do { const bf16* yr_ = Yb + (size_t)(m) * D + 4 * lane; \
        _Pragma("unroll") for (int q = 0; q < 8; ++q) { Y[q] = *(const v2u*)(yr_ + 256 * q); \
            if constexpr (XIN_F32) X[q] = __builtin_nontemporal_load((const xraw_t*)(Xsrc + (size_t)(m) * D + 4 * lane + 256 * q)); \
            else X[q] = __builtin_nontemporal_load((const xraw_t*)(Xb + (size_t)(m) * D + 4 * lane + 256 * q)); } } while (0)
#define T1_PROC(Y, XR, m) do { float ss = 0.f; f32x4 yf[8], X[8]; \
        _Pragma("unroll") for (int q = 0; q < 8; ++q) { yf[q] = (f32x4){bflo(Y[q].x), bfhi(Y[q].x), bflo(Y[q].y), bfhi(Y[q].y)}; \
            ss += (yf[q][0] * yf[q][0] + yf[q][1] * yf[q][1]) + (yf[q][2] * yf[q][2] + yf[q][3] * yf[q][3]); } \
        const float r = 1.0f / sqrtf(wave_sum(ss) * (1.0f / D) + EPS); float s2 = 0.f; \
        _Pragma("unroll") for (int q = 0; q < 8; ++q) { \
            if constexpr (XIN_F32) X[q] = XR[q]; else X[q] = (f32x4){bflo(XR[q].x), bfhi(XR[q].x), bflo(XR[q].y), bfhi(XR[q].y)}; \
            X[q] = X[q] + V0[64 * q + lane] * (yf[q] * r); \
            if constexpr (XOUT_F32) __builtin_nontemporal_store(X[q], (f32x4*)(A.out + (size_t)(m) * D + 4 * lane + 256 * q)); \
            else { v2u w; w.x = pk2(X[q][0], X[q][1]); w.y = pk2(X[q][2], X[q][3]); __builtin_nontemporal_store(w, (v2u*)(Xb + (size_t)(m) * D + 4 * lane + 256 * q)); } \
            s2 += (X[q][0] * X[q][0] + X[q][1] * X[q][1]) + (X[q][2] * X[q][2] + X[q][3] * X[q][3]); } \
        if (has_next) { const float r2 = 1.0f / sqrtf(wave_sum(s2) * (1.0f / D) + EPS); bf16* hw_ = Hb + (size_t)(m) * D + 4 * lane; \
            _Pragma("unroll") for (int q = 0; q < 8; ++q) { const f32x4 h = (X[q] * r2) * V1[64 * q + lane] + V2[64 * q + lane]; \
                v2u w; w.x = pk2(h[0], h[1]); w.y = pk2(h[2], h[3]); st8_wt(hw_ + 256 * q, w); } } } while (0)
        T1_LOAD(ya, xa, m0);
        T1_LOAD(yb, xb, m0 + 1);
        T1_PROC(ya, xa, m0);
        T1_LOAD(ya, xa, m0 + 2);
        T1_PROC(yb, xb, m0 + 1);
        T1_LOAD(yb, xb, m0 + 3);
        T1_PROC(ya, xa, m0 + 2);
        T1_PROC(yb, xb, m0 + 3);
#undef T1_LOAD
#undef T1_PROC
        __syncthreads();
    }
}
__device__ __forceinline__ void t1_phase(const Args& A_, int l, int j, LAS unsigned char* lds) {
    PHASE_IDS(); Args A = A_; A.ws = opq(A_.ws); A.out = opq(A_.out);
    if (l == 0 && j == 0) t1_body<true, false>(A, l, j, lds, tid, lane, wave, G);
    else if (l == DEPTH - 1 && j == 2) t1_body<false, true>(A, l, j, lds, tid, lane, wave, G);
    else t1_body<false, false>(A, l, j, lds, tid, lane, wave, G);
    {
        const int cl = (j == 2) ? l + 1 : l, lo = (j == 0) ? 33792 + CONV_TAIL_X : (j == 1) ? 16896 : CONV_TAIL_X, hi = (j == 0) ? PER_L : (j == 1) ? 16896 + 11264 : 11264;
        if (cl < DEPTH) convert_items(A, cl, lo, hi, gw, NGW, lane);
    }
}
constexpr int ATT_NUNITS = 640;
static_assert(att::SHM_ATTN <= RING_BYTES && pg8::STAGE_BYTES <= RING_BYTES && MISC_OFF + 128 <= LDS_BYTES, "LDS map");
constexpr int P_QA = 0, P_KA = 768, P_VA = 1024, P_QB = 1280, P_KB = 1792, P_VB = 2304, P_QC = 2816, P_KC = 3584, P_VC = 3840;
constexpr int C_KA = 0, C_VA = 256, C_KB = 512, C_VB = 1024, C_KC = 1536, C_VC = 1792;
constexpr int O_A = 0, O_B = 768, O_C = 1280;
__device__ __forceinline__ void attn_phase(const Args& A_, int l, char* lds, volatile LAS unsigned* MISC) {
    PHASE_IDS(); Args A = A_; A.ws = opq(A_.ws);
    gu32* head = (gu32*)(A.ws + WS_CTL) + CW_Q + 64 * l;
    const bf16* P = (const bf16*)(A.ws + WS_P); bf16* O = (bf16*)(A.ws + WS_O);
    const bf16* CA = (const bf16*)(A.ws + WS_CACHE) + (size_t)l * 2 * 512 * 2048;
    const float lam_init = (l == 0) ? 0.2f : (l == 1) ? 0.35550906759f : (l == 2) ? 0.47071301834f : 0.55605820416f;
    float lam;
    { const float* bl = A.in[I_LAM] + l * 256; const float a = bl[lane] * bl[64 + lane], b = bl[128 + lane] * bl[192 + lane];
      lam = expf(wave_sum(a)) - expf(wave_sum(b)) + lam_init; lam = __builtin_bit_cast(float, __builtin_amdgcn_readfirstlane(__builtin_bit_cast(int, lam))); }
    for (;;) {
        __syncthreads();
        if (tid == 0) MISC[16] = __hip_atomic_fetch_add(head, 1u, RLX_AGENT);
        __syncthreads();
        const int u = __builtin_amdgcn_readfirstlane((int)MISC[16]);
        if (u >= ATT_NUNITS) break;
        int kind, lat, b, qb, h, rows = 256;
        if (u < 96) { const int i = u; kind = 2; lat = 1; b = i / 48; qb = (i / 6) & 7; h = i % 6; }
        else if (u < 224) { const int i = u - 96; kind = 1; lat = 1; rows = 128; b = i >> 6; qb = (i >> 2) & 15; h = i & 3; }
        else if (u < 320) { const int i = u - 224; kind = 0; lat = 1; b = i / 48; qb = (i / 6) & 7; h = i % 6; }
        else if (u < 416) { const int i = u - 320; kind = 0; lat = 0; b = i / 6; qb = 0; h = i % 6; }
        else if (u < 512) { const int i = u - 416; kind = 2; lat = 0; b = i / 6; qb = 0; h = i % 6; }
        else { const int i = u - 512; kind = 1; lat = 0; rows = 128; b = i >> 3; qb = (i >> 2) & 1; h = i & 3; }
        const int kvh = (kind == 1) ? h : h / 3;
        const int qcol = (kind == 0 ? P_QA : kind == 1 ? P_QB : P_QC) + h * 128;
        const int kcol = (kind == 0 ? P_KA : kind == 1 ? P_KB : P_KC) + kvh * 128, vcol = (kind == 0 ? P_VA : kind == 1 ? P_VB : P_VC) + kvh * 128;
        const int ckcol = (kind == 0 ? C_KA : kind == 1 ? C_KB : C_KC) + kvh * 128, cvcol = (kind == 0 ? C_VA : kind == 1 ? C_VB : C_VC) + kvh * 128;
        const int ocol = (kind == 0 ? O_A : kind == 1 ? O_B : O_C) + h * 128;
        const int seq0 = lat ? M_CTX + b * 2048 : b * 256;
        const int m0 = seq0 + qb * rows;
        att::AttnUnit a;
        a.Q = P + (size_t)m0 * NIN + qcol; a.ldq = NIN;
        if (lat) { a.K0 = CA + (size_t)b * 512 * 2048 + ckcol; a.V0 = CA + (size_t)b * 512 * 2048 + cvcol; a.ld0 = 2048; a.n0 = 8; }
        else { a.K0 = P; a.V0 = P; a.ld0 = NIN; a.n0 = 0; }
        int klo = 0, khi = lat ? 2048 : 256;
        a.win = 0;
        if (lat && kind == 0) { klo = qb * 256 - 128; if (klo < 0) klo = 0; khi = qb * 256 + 384; if (khi > 2048) khi = 2048; a.win = 1; }
        a.K1 = P + (size_t)(seq0 + klo) * NIN + kcol; a.V1 = P + (size_t)(seq0 + klo) * NIN + vcol; a.ld1 = NIN; a.n1 = (khi - klo) >> 6;
        a.qpos0 = qb * 256; a.kpos1 = klo; a.koffB = 0;
        a.has_sink = (kind == 0); a.sink = (kind == 0) ? A.in[I_SINK][l * 6 + h] : 0.f;
        a.O = O + (size_t)m0 * D + ocol; a.ldo = D; a.pair = (kind == 1);
        a.lam = lam; a.post = 1.0f - lam_init; a.gsub = A.in[I_SUBLN] + l * 128;
        if (kind != 1) att::attn_body<8>(a, lds); else att::attn_body<4>(a, lds);
    }
}

constexpr int NPH = 2 + DEPTH * 10;
__global__ void __launch_bounds__(NWAVES * 64, 2) fwd(Args args) {
    extern __shared__ __attribute__((aligned(16))) unsigned char lds[];
    LAS unsigned char* L = (LAS unsigned char*)lds;
    volatile LAS unsigned* MISC = (volatile LAS unsigned*)(L + MISC_OFF);
    const Args& A = args;
    for (int u = threadIdx.x; u < (LDS_BYTES - LDSCTL_OFF) / 4; u += NWAVES * 64) ((LAS unsigned*)(L + LDSCTL_OFF))[u] = 0u;
    __syncthreads();
    gu32* ctl = (gu32*)(args.ws + WS_CTL);
    XcdBarrier bar = xcd_barrier_post((unsigned*)(ctl + CW_BAR), MISC + 8);
    const int lo = args.ph_lo, hi = args.ph_hi; int ph = 0;
#define PH_ON() (ph >= lo && ph < hi)
#define PH_END() do { if (ph + 1 < hi) xcd_barrier(bar); } while (0)

    #ifndef NO_P0
    if (PH_ON()) { p0a(A, L); PH_END(); } ++ph;
#endif
    #ifndef NO_T
    if (PH_ON()) { t0_phase(A); PH_END(); } ++ph;
#endif

    for (int sl = 0; sl < 3 * DEPTH; ++sl) {
        const int l = sl / 3, j = sl % 3;
        if (j != 1) {
            const int s = j >> 1;
#ifndef NO_GEMM
            if (PH_ON()) {
                unsigned char* wsq = opq(args.ws);
                pg8::Gemm g{(const pg8::bf16_t*)(wsq + WS_H), (const pg8::bf16_t*)(wsq + WS_WGU) + (size_t)(l * 2 + s) * 11264 * D, M, 11264, D};
                pg8::StaticOrder S; S.init(M, 11264, (int)gridDim.x, (int)blockIdx.x);
                pg8::EpiSwiglu E{(pg8::bf16_t*)(wsq + WS_ACT), FF};
                pg8::gemm_phase<pg8::EpiSwiglu, pg8::StaticOrder, true, true>(L + RING_OFF, g, S, E);
                {
                    const int G_ = (int)gridDim.x, rem = (M / 256 * 44) % G_, c_ = (int)blockIdx.x;
                    if (rem == 0 || c_ >= rem) { Args Aq = args; Aq.ws = wsq; const int t_ = opq_tid();
                        const int c0_ = rem == 0 ? 0 : rem;
                        const int w_ = (c_ - c0_) * NWAVES + __builtin_amdgcn_readfirstlane(t_ >> 6), nw_ = (G_ - c0_) * NWAVES;
                        convert_items(Aq, l, 16896 * s + 11264, 16896 * s + 16896, w_, nw_, t_ & 63);
                        const int xl = l + s, xlo = s ? 0 : 33792;
                        if (xl < DEPTH) convert_items(Aq, xl, xlo, xlo + CONV_TAIL_X, w_, nw_, t_ & 63); }
                }
                PH_END();
            } ++ph;
            if (PH_ON()) {
                unsigned char* wsq = opq(args.ws);
                pg8::Gemm g{(const pg8::bf16_t*)(wsq + WS_ACT), (const pg8::bf16_t*)(wsq + WS_WD) + (size_t)(l * 2 + s) * D * FF, M, D, FF};
                pg8::StaticOrder S; S.init(M, D, (int)gridDim.x, (int)blockIdx.x);
                pg8::EpiY16 E{(pg8::bf16_t*)(wsq + WS_Y), D};
                pg8::gemm_phase<pg8::EpiY16, pg8::StaticOrder, true, true>(L + RING_OFF, g, S, E);
                PH_END();
            } ++ph;
#endif
        } else {
#ifndef NO_GEMM
            if (PH_ON()) {
                unsigned char* wsq = opq(args.ws);
                pg8::Gemm g{(const pg8::bf16_t*)(wsq + WS_H), (const pg8::bf16_t*)(wsq + WS_WIN) + (size_t)l * NIN * D, M, NIN, D};
                pg8::StaticOrder S; S.init(M, NIN, (int)gridDim.x, (int)blockIdx.x);
                pg8::EpiQKV E{(pg8::bf16_t*)(wsq + WS_P), opq(args.out), l, (const float*)(wsq + WS_ROPE), opq(args.in[I_QN]), opq(args.in[I_KN]), (LAS float*)(L + NORM_OFF)};
                pg8::gemm_phase<pg8::EpiQKV, pg8::StaticOrder, true, true>(L + RING_OFF, g, S, E);
                PH_END();
            } ++ph;
#endif
                        #ifndef NO_ATTN
            if (PH_ON()) { attn_phase(A, l, (char*)lds, MISC); PH_END(); } ++ph;
#endif
#ifndef NO_GEMM
            if (PH_ON()) {
                unsigned char* wsq = opq(args.ws);
                pg8::Gemm g{(const pg8::bf16_t*)(wsq + WS_O), (const pg8::bf16_t*)(wsq + WS_WOUT) + (size_t)l * D * D, M, D, D};
                pg8::StaticOrder S; S.init(M, D, (int)gridDim.x, (int)blockIdx.x);
                pg8::EpiY16 E{(pg8::bf16_t*)(wsq + WS_Y), D};
                pg8::gemm_phase<pg8::EpiY16, pg8::StaticOrder, true, true>(L + RING_OFF, g, S, E);
                PH_END();
            } ++ph;
#endif
        }
#ifndef NO_T
        if (PH_ON()) { t1_phase(A, l, j, L); PH_END(); } ++ph;
#endif
    }
    if (blockIdx.x == 0 && threadIdx.x == 0 && hi >= ph) {
        if (__hip_atomic_load((gu32*)(ctl + CW_BAR + XB_TMO), RLX_AGENT) != 0u) args.out[0] = __builtin_nanf("");
    }
#undef PH_ON
#undef PH_END
}

extern "C" void kernel_launch(void* const* d_in, const int* in_sizes, int n_in, void* d_out, int out_size, void* d_ws, size_t ws_size, hipStream_t stream) {
    static int grid = 0;
    if (grid == 0) {
        if (n_in != 24 || in_sizes[0] != M_CTX * D || (size_t)out_size != OUT_TOTAL || ws_size < WS_END) {
            fprintf(stderr, "kernel_launch: shape mismatch: n_in %d in0 %d out %d ws %zu (need >= %zu)\n", n_in, n_in > 0 ? in_sizes[0] : -1, out_size, ws_size, (size_t)WS_END); grid = -1; return; }
        int dev = 0, cus = 0, per_cu = 0;
        if (hipGetDevice(&dev) != hipSuccess || hipDeviceGetAttribute(&cus, hipDeviceAttributeMultiprocessorCount, dev) != hipSuccess) { grid = -1; return; }
        if (hipFuncSetAttribute((const void*)fwd, hipFuncAttributeMaxDynamicSharedMemorySize, LDS_BYTES) != hipSuccess) { fprintf(stderr, "kernel_launch: hipFuncSetAttribute failed\n"); grid = -1; return; }
        if (hipOccupancyMaxActiveBlocksPerMultiprocessor(&per_cu, (const void*)fwd, NWAVES * 64, LDS_BYTES) != hipSuccess || per_cu < 1)
            fprintf(stderr, "kernel_launch: note: occupancy query reports %d workgroups per CU\n", per_cu);
        (void)hipGetLastError();
        grid = cus;
    }
    if (grid < 0) return;
    if (hipMemsetAsync((char*)d_ws + WS_CTL, 0, CTL_ZERO_BYTES, stream) != hipSuccess) { fprintf(stderr, "kernel_launch: memset failed\n"); return; }
    Args a{};
    for (int i = 0; i < 24; ++i) a.in[i] = (const float*)d_in[i];
    a.out = (float*)d_out; a.ws = (unsigned char*)d_ws; a.ph_lo = 0; a.ph_hi = NPH;
    hipLaunchKernelGGL(fwd, dim3(grid), dim3(NWAVES * 64), LDS_BYTES, stream, a);
    const hipError_t le = hipPeekAtLastError();
    if (le != hipSuccess) fprintf(stderr, "kernel_launch: launch failed: %s\n", hipGetErrorName(le));
}
```

```cpp
#include <hip/hip_runtime.h>
#include <hip/hip_bf16.h>
#include <cstdio>
#include <cstdint>
#include <cmath>
#include <type_traits>
template <int K> __device__ __forceinline__ float xshfl(float v) { return __builtin_bit_cast(float, __builtin_amdgcn_ds_swizzle(__builtin_bit_cast(int, v), (K << 10) | 0x1f)); }
__device__ __forceinline__ float wave_sum(float v) {
    v += xshfl<1>(v); v += xshfl<2>(v); v += xshfl<4>(v); v += xshfl<8>(v); v += xshfl<16>(v);
    auto rr = __builtin_amdgcn_permlane32_swap(__float_as_uint(v), __float_as_uint(v), false, false);
    return __uint_as_float(rr[0]) + __uint_as_float(rr[1]);
}
__device__ __forceinline__ size_t opq0() { size_t z; asm volatile("s_mov_b64 %0, 0" : "=s"(z)); return z; }
template <class T> __device__ __forceinline__ T* opq(T* p) { return p + opq0(); }
__device__ __forceinline__ int opq_tid() { int t = threadIdx.x; asm volatile("" : "+v"(t)); return t; }

typedef unsigned wt_u4 __attribute__((ext_vector_type(4)));
typedef unsigned wt_u2 __attribute__((ext_vector_type(2)));
typedef float wt_f4 __attribute__((ext_vector_type(4)));
__device__ __forceinline__ void st16_wt(void* p, wt_u4 v) { asm volatile("global_store_dwordx4 %0, %1, off sc1" :: "v"(p), "v"(v) : "memory"); }
__device__ __forceinline__ void st16_wt(void* p, wt_f4 v) { asm volatile("global_store_dwordx4 %0, %1, off sc1" :: "v"(p), "v"(v) : "memory"); }
__device__ __forceinline__ void st8_wt(void* p, wt_u2 v) { asm volatile("global_store_dwordx2 %0, %1, off sc1" :: "v"(p), "v"(v) : "memory"); }
namespace pg8 {
#define PG8_LAS __attribute__((address_space(3)))
typedef unsigned short bf16_t;
typedef short bf16x8 __attribute__((ext_vector_type(8)));
typedef float f32x4 __attribute__((ext_vector_type(4)));
typedef unsigned u32x4 __attribute__((ext_vector_type(4)));
constexpr int BM = 256, BK = 64, HALF = 128, HTB = HALF * BK * 2  , STAGE_BYTES = 8 * HTB, NXCD = 8, WGM = 8;

__host__ __device__ __forceinline__ int lds_byte(int r, int c) { const int st = (r >> 4) * 2 + (c >> 5), rr = r & 15, cc = c & 31, ob = rr * 64 + cc * 2; return st * 1024 + (ob ^ (((ob >> 9) & 1) << 5)); }
__host__ __device__ __forceinline__ void stage_rc(int b, int& R, int& C) { const int st = b / 1024, sb = b % 1024, swz = sb ^ (((sb >> 9) & 1) << 5); R = (st >> 1) * 16 + swz / 64; C = (st & 1) * 32 + (swz % 64) / 2; }
__host__ __device__ __forceinline__ int perm32(int rho) { const int n = rho >> 4, i = rho & 15; return 8 * (i >> 2) + 4 * n + (i & 3); }

struct Unit { int pm, pn; };
struct Gemm { const bf16_t* A; const bf16_t* Bt; int M, N, K; };

struct StaticOrder {
    int nM, nN, nwg, G, c;
    __host__ __device__ void init(int M, int N, int G_, int c_) { nM = M / BM; nN = N / BM; nwg = nM * nN; G = G_; c = c_; }
    __host__ __device__ bool next(int i, Unit& u) const {
        const long L = (long)i * G + c; if (L >= nwg) return false;
        int wgid = (int)L; { const int q = nwg / NXCD, r = nwg % NXCD, xcd = wgid % NXCD, off = wgid / NXCD; wgid = (xcd < r ? xcd * (q + 1) : r * (q + 1) + (xcd - r) * q) + off; }
        const int nig = WGM * nN, gid = wgid / nig, fm = gid * WGM, gsz = (nM - fm) < WGM ? (nM - fm) : WGM;
        u.pm = fm + ((wgid % nig) % gsz); u.pn = (wgid % nig) / gsz; return true;
    }
    __device__ __forceinline__ void a_ready(const Unit&) const {}
    __device__ __forceinline__ void done(const Unit&) const {}
};

__device__ __forceinline__ unsigned cvt_pk_bf16(float lo, float hi) { unsigned r; asm volatile("v_cvt_pk_bf16_f32 %0, %1, %2" : "=v"(r) : "v"(lo), "v"(hi)); return r; }
typedef float f32x2 __attribute__((ext_vector_type(2)));
typedef float f32x2 __attribute__((ext_vector_type(2)));
__device__ __forceinline__ f32x2 swiglu_pk(f32x2 g, f32x2 u) {
    const f32x2 t = g * (-1.4426950408889634f); f32x2 e; e.x = __builtin_amdgcn_exp2f(t.x); e.y = __builtin_amdgcn_exp2f(t.y);
    const f32x2 d = e + 1.0f; f32x2 r; r.x = __builtin_amdgcn_rcpf(d.x); r.y = __builtin_amdgcn_rcpf(d.y);
    return (g * u) * r;
}
struct EpiSwiglu {
    static constexpr bool PERM = true, AFTER_DRAIN = false;
    bf16_t* O; int ldc;
    __device__ __forceinline__ void operator()(const f32x4 (&acc)[2][2][4][2], const Unit& u, int wr, int wc, int fr, int fq) const {
        const int row0 = u.pm * BM + wr * 64 + fr, col0 = u.pn * HALF + wc * 32 + 8 * fq;
#pragma unroll
        for (int ai = 0; ai < 2; ++ai)
#pragma unroll
            for (int m = 0; m < 4; ++m) {
                bf16_t* rowp = O + (size_t)(row0 + ai * HALF + m * 16) * ldc + col0;
                const f32x4 g0 = acc[ai][0][m][0], g1 = acc[ai][0][m][1], u0 = acc[ai][1][m][0], u1 = acc[ai][1][m][1];
                const f32x2 a = swiglu_pk((f32x2){g0[0], g0[1]}, (f32x2){u0[0], u0[1]}), b = swiglu_pk((f32x2){g0[2], g0[3]}, (f32x2){u0[2], u0[3]});
                const f32x2 c = swiglu_pk((f32x2){g1[0], g1[1]}, (f32x2){u1[0], u1[1]}), d = swiglu_pk((f32x2){g1[2], g1[3]}, (f32x2){u1[2], u1[3]});
                u32x4 w; w.x = cvt_pk_bf16(a.x, a.y); w.y = cvt_pk_bf16(b.x, b.y); w.z = cvt_pk_bf16(c.x, c.y); w.w = cvt_pk_bf16(d.x, d.y);
                *(u32x4*)rowp = w;
            }
    }
};
struct EpiY16 {
    static constexpr bool PERM = true, AFTER_DRAIN = false;
    bf16_t* O; int ldc;
    __device__ __forceinline__ void operator()(const f32x4 (&acc)[2][2][4][2], const Unit& u, int wr, int wc, int fr, int fq) const {
        const int row0 = u.pm * BM + wr * 64 + fr, col0 = u.pn * BM + wc * 32 + 8 * fq;
#pragma unroll
        for (int ai = 0; ai < 2; ++ai)
#pragma unroll
            for (int m = 0; m < 4; ++m) {
                bf16_t* rowp = O + (size_t)(row0 + ai * HALF + m * 16) * ldc + col0;
#pragma unroll
                for (int bj = 0; bj < 2; ++bj) { const f32x4 v0 = acc[ai][bj][m][0], v1 = acc[ai][bj][m][1];
                    u32x4 w; w.x = cvt_pk_bf16(v0[0], v0[1]); w.y = cvt_pk_bf16(v0[2], v0[3]); w.z = cvt_pk_bf16(v1[0], v1[1]); w.w = cvt_pk_bf16(v1[2], v1[3]);
                    *(u32x4*)(rowp + bj * HALF) = w; }
            }
    }
};
struct EpiF32 {
    static constexpr bool PERM = false, AFTER_DRAIN = false;
    float* O; int ldc;
    __device__ __forceinline__ void operator()(const f32x4 (&acc)[2][2][4][2], const Unit& u, int wr, int wc, int fr, int fq) const {
        const int row0 = u.pm * BM + wr * 64 + fr, col0 = u.pn * BM + wc * 32 + 4 * fq;
#pragma unroll
        for (int ai = 0; ai < 2; ++ai)
#pragma unroll
            for (int m = 0; m < 4; ++m) {
                float* rowp = O + (size_t)(row0 + ai * HALF + m * 16) * ldc + col0;
#pragma unroll
                for (int bj = 0; bj < 2; ++bj)
#pragma unroll
                    for (int n = 0; n < 2; ++n) *(f32x4*)(rowp + bj * HALF + n * 16) = acc[ai][bj][m][n];
            }
    }
};
struct EpiQKV {
    static constexpr bool PERM = true, AFTER_DRAIN = false;
    bf16_t* P; float* out; int layer; const float* rope; const float* qn; const float* kn; PG8_LAS float* part;
    __device__ __forceinline__ void operator()(const f32x4 (&acc)[2][2][4][2], const Unit& u, int wr, int wc, int fr, int fq) const {
        const int pn = u.pn, pm = u.pm, col0 = pn * BM + wc * 32 + 8 * fq;
        const bool lat = pm >= 16, norm = pn >= 11 && pn <= 14;
        const int rtype = (pn <= 3 || norm) ? 1 : ((pn >= 5 && pn <= 8) ? 2 : 0);
        const int a = (rtype == 2 ? 16 * (wc & 1) : 16 * wc) + 4 * fq;
        float* ob = nullptr; int W = 256, c0 = 0;
        if (!lat) {
            if (pn == 3) ob = out + 16777216; else if (pn == 4) ob = out + 20971520;
            else if (pn == 7) { ob = out + 25165824; W = 512; } else if (pn == 8) { ob = out + 25165824; W = 512; c0 = 256; }
            else if (pn == 9) { ob = out + 33554432; W = 512; } else if (pn == 10) { ob = out + 33554432; W = 512; c0 = 256; }
            else if (pn == 14) ob = out + 41943040; else if (pn == 15) ob = out + 46137344;
        }
        f32x4 g1 = {1.f, 1.f, 1.f, 1.f}, g2 = g1;
        f32x4 csn[2] = {g1, g1};
        if (norm) {
            const float* g = (pn == 14 ? kn : qn) + layer * 128; g1 = *(const f32x4*)(g + a); g2 = *(const f32x4*)(g + 64 + a);
#pragma unroll
            for (int ai = 0; ai < 2; ++ai)
#pragma unroll
                for (int m = 0; m < 4; ++m)
#pragma unroll
                    for (int bj = 0; bj < 2; ++bj) { const f32x4 v0 = acc[ai][bj][m][0], v1 = acc[ai][bj][m][1];
                        float ss = (v0[0] * v0[0] + v0[1] * v0[1]) + (v0[2] * v0[2] + v0[3] * v0[3]) + (v1[0] * v1[0] + v1[1] * v1[1]) + (v1[2] * v1[2] + v1[3] * v1[3]);
                        ss += __builtin_bit_cast(float, __builtin_amdgcn_ds_swizzle(__builtin_bit_cast(int, ss), (16 << 10) | 0x1f));
                        { auto rr = __builtin_amdgcn_permlane32_swap(__float_as_uint(ss), __float_as_uint(ss), false, false); ss = __uint_as_float(rr[0]) + __uint_as_float(rr[1]); }
                        if (fq == 0) part[((ai * HALF + wr * 64 + m * 16 + fr) * 2 + bj) * 4 + wc] = ss; }
            asm volatile("s_waitcnt lgkmcnt(0)" ::: "memory"); __builtin_amdgcn_s_barrier(); asm volatile("" ::: "memory");
        }
#pragma unroll
        for (int ai = 0; ai < 2; ++ai)
#pragma unroll
            for (int m = 0; m < 4; ++m) {
                const int t = wr * 64 + fr + ai * HALF + m * 16;
                bf16_t* rowp = P + (size_t)(pm * BM + t) * 4096 + col0;
                f32x4 cs2[2], sn2[2];
                if ((m & 1) == 0) {
#pragma unroll
                    for (int e2 = 0; e2 < 2; ++e2) { cs2[e2] = (f32x4){1.f, 1.f, 1.f, 1.f}; sn2[e2] = (f32x4){0.f, 0.f, 0.f, 0.f};
                        if (lat && rtype != 0) { const int tok = (pm * BM + t + 16 * e2) & 2047;
                            const float* cp = rtype == 1 ? rope + tok * 64 + a : rope + 262144 + tok * 32 + a;
                            cs2[e2] = *(const f32x4*)cp; sn2[e2] = *(const f32x4*)(cp + (rtype == 1 ? 131072 : 65536)); } }
                    csn[0] = cs2[1]; csn[1] = sn2[1];
                }
                const f32x4 cs = (m & 1) == 0 ? cs2[0] : csn[0], sn = (m & 1) == 0 ? sn2[0] : csn[1];
#pragma unroll
                for (int bj = 0; bj < 2; ++bj) {
                    const f32x4 v0 = acc[ai][bj][m][0], v1 = acc[ai][bj][m][1];
                    if (rtype == 0) {
                        u32x4 w; w.x = cvt_pk_bf16(v0[0], v0[1]); w.y = cvt_pk_bf16(v0[2], v0[3]); w.z = cvt_pk_bf16(v1[0], v1[1]); w.w = cvt_pk_bf16(v1[2], v1[3]);
                        *(u32x4*)(rowp + bj * HALF) = w;
                        if (ob) { float* o = ob + (size_t)((pm * 4 + layer) * 256 + t) * W + c0 + wc * 32 + 8 * fq + bj * HALF; *(f32x4*)o = v0; *(f32x4*)(o + 4) = v1; }
                    } else {
                        f32x4 x1 = {v0[0], v0[2], v1[0], v1[2]}, x2 = {v0[1], v0[3], v1[1], v1[3]};
                        if (norm) { const f32x4 pt = *(const PG8_LAS f32x4*)(part + ((ai * HALF + wr * 64 + m * 16 + fr) * 2 + bj) * 4);
                            const float r = 1.0f / sqrtf(((pt[0] + pt[1]) + (pt[2] + pt[3])) * (1.0f / 128.0f) + 1e-6f); x1 = x1 * r * g1; x2 = x2 * r * g2; }
                        const f32x4 o1 = x1 * cs - x2 * sn, o2 = x2 * cs + x1 * sn;
                        u32x4 w; w.x = cvt_pk_bf16(o1[0], o2[0]); w.y = cvt_pk_bf16(o1[1], o2[1]); w.z = cvt_pk_bf16(o1[2], o2[2]); w.w = cvt_pk_bf16(o1[3], o2[3]);
                        *(u32x4*)(rowp + bj * HALF) = w;
                        if (ob) { float* o = ob + (size_t)((pm * 4 + layer) * 256 + t) * W + c0 + bj * HALF + (rtype == 2 ? (wc >> 1) * 64 : 0) + a;
                            *(f32x4*)o = o1; *(f32x4*)(o + (rtype == 2 ? 32 : 64)) = o2; }
                    }
                }
            }
    }
};
template <class Epi, class Sched, bool ALIGN_EPI = false, bool SP2 = false>
__device__ __forceinline__ void gemm_phase(PG8_LAS unsigned char* lds, const Gemm g, const Sched& S, const Epi& E) {
    int tid_ = threadIdx.x; asm volatile("" : "+v"(tid_));
    const int tid = tid_, wid = __builtin_amdgcn_readfirstlane(tid >> 6), lane = tid & 63, wr = wid >> 2, wc = wid & 3, fr = lane & 15, fq = lane >> 4;
    const int K = g.K, nt = K / BK;
    unsigned voffA[2], voffB[2];
#pragma unroll
    for (int i = 0; i < 2; ++i) { int R, C; stage_rc(tid * 16 + i * 8192, R, C); const int Rb = Epi::PERM ? ((R & ~31) + perm32(R & 31)) : R;
        voffA[i] = (unsigned)(R * K + C) * 2u; voffB[i] = (unsigned)(Rb * K + C) * 2u; }
    const size_t kstep = (size_t)(BK * 2);
    const size_t hstep = (size_t)HALF * K * 2;
    const size_t tstep = 2 * hstep;
    const unsigned ldsw = (unsigned)wid * 1024u;
    const int aoff = lds_byte(wr * 64 + fr, fq * 8), boff = lds_byte(wc * 32 + fr, fq * 8);
#define PG8_SA(b, h) (((b) * 2 + (h)) * HTB)
#define PG8_SB(b, h) ((4 + (b) * 2 + (h)) * HTB)
#define PG8_STAGE(bufoff, gbase, voff) do { _Pragma("unroll") for (int _i = 0; _i < 2; ++_i) \
        __builtin_amdgcn_global_load_lds((const unsigned*)((const char*)(gbase) + (voff)[_i]), (PG8_LAS unsigned*)(lds + (bufoff) + ldsw + _i * 8192), 16, 0, 0); } while (0)
#define PG8_LDA(dst, b, h) do { _Pragma("unroll") for (int m = 0; m < 4; ++m) _Pragma("unroll") for (int k = 0; k < 2; ++k) dst[m][k] = *(const PG8_LAS bf16x8*)(lds + PG8_SA(b, h) + aoff + m * 2048 + k * 1024); } while (0)
#define PG8_LDB(dst, b, h) do { _Pragma("unroll") for (int n = 0; n < 2; ++n) _Pragma("unroll") for (int k = 0; k < 2; ++k) dst[n][k] = *(const PG8_LAS bf16x8*)(lds + PG8_SB(b, h) + boff + n * 2048 + k * 1024); } while (0)
#define PG8_MMA(ai, bj, At, Bt) do { __builtin_amdgcn_s_setprio(1); _Pragma("unroll") for (int m = 0; m < 4; ++m) _Pragma("unroll") for (int n = 0; n < 2; ++n) _Pragma("unroll") for (int k = 0; k < 2; ++k) \
        acc[ai][bj][m][n] = __builtin_amdgcn_mfma_f32_16x16x32_bf16(Bt[n][k], At[m][k], acc[ai][bj][m][n], 0, 0, 0); __builtin_amdgcn_s_setprio(0); } while (0)
#define PG8_WAIT_V(n) asm volatile("s_waitcnt vmcnt(" #n ")" ::: "memory")
#define PG8_WAIT_L(n) asm volatile("s_waitcnt lgkmcnt(" #n ")" ::: "memory")
#define PG8_BAR __builtin_amdgcn_s_barrier()
#define PG8_SCHED __builtin_amdgcn_sched_barrier(0)
    Unit cur, nxt; int ui = 0;
    if (!S.next(0, cur)) return;
    f32x4 acc[2][2][4][2];
#pragma unroll
    for (int a = 0; a < 2; ++a)
#pragma unroll
        for (int b = 0; b < 2; ++b)
#pragma unroll
            for (int m = 0; m < 4; ++m)
#pragma unroll
                for (int n = 0; n < 2; ++n) acc[a][b][m][n] = (f32x4){0.f, 0.f, 0.f, 0.f};
    bf16x8 At[4][2], B0[2][2], B1[2][2];
    const char* cA = (const char*)g.A + (size_t)cur.pm * tstep; const char* cB = (const char*)g.Bt + (size_t)cur.pn * tstep;
    S.a_ready(cur);
    if constexpr (SP2) {
        PG8_STAGE(PG8_SB(0, 0), cB, voffB); PG8_STAGE(PG8_SB(0, 1), cB + hstep, voffB); PG8_STAGE(PG8_SA(0, 0), cA, voffA); PG8_STAGE(PG8_SA(0, 1), cA + hstep, voffA);
        if (wr == 1) PG8_BAR;
        PG8_WAIT_V(2); PG8_BAR;
        PG8_STAGE(PG8_SB(1, 0), cB + kstep, voffB); PG8_STAGE(PG8_SA(1, 0), cA + kstep, voffA); PG8_STAGE(PG8_SB(1, 1), cB + hstep + kstep, voffB);
        PG8_WAIT_V(6); PG8_BAR;
    } else {
        PG8_STAGE(PG8_SB(0, 0), cB, voffB); PG8_STAGE(PG8_SA(0, 0), cA, voffA); PG8_STAGE(PG8_SB(0, 1), cB + hstep, voffB); PG8_STAGE(PG8_SA(0, 1), cA + hstep, voffA);
        if (wr == 1) PG8_BAR;
        PG8_WAIT_V(4); PG8_BAR;
        PG8_STAGE(PG8_SB(1, 0), cB + kstep, voffB); PG8_STAGE(PG8_SA(1, 0), cA + kstep, voffA); PG8_STAGE(PG8_SB(1, 1), cB + hstep + kstep, voffB);
        PG8_WAIT_V(6); PG8_BAR;
    }
    for (;;) {
        const bool has_next = S.next(ui + 1, nxt);
        const char* nA = has_next ? (const char*)g.A + (size_t)nxt.pm * tstep : cA; const char* nB = has_next ? (const char*)g.Bt + (size_t)nxt.pn * tstep : cB;
        for (int t = 0; t < nt; t += 2) {
            const bool last = (t == nt - 2);
            const char* a1 = cA + (size_t)(t + 1) * kstep;
            const char* a2 = last ? nA : cA + (size_t)(t + 2) * kstep; const char* b2 = last ? nB : cB + (size_t)(t + 2) * kstep;
            const char* a3 = a2 + kstep; const char* b3 = b2 + kstep;
            if (last && has_next) S.a_ready(nxt);
            if constexpr (SP2) {
            PG8_LDB(B0, 0, 0); PG8_LDB(B1, 0, 1); PG8_SCHED; PG8_LDA(At, 0, 0); PG8_STAGE(PG8_SA(1, 1), a1 + hstep, voffA);
            PG8_WAIT_V(8); PG8_WAIT_L(0); PG8_BAR; PG8_MMA(0, 0, At, B0); PG8_MMA(0, 1, At, B1); PG8_BAR; PG8_SCHED;
            PG8_LDA(At, 0, 1); PG8_STAGE(PG8_SB(0, 0), b2, voffB); PG8_STAGE(PG8_SB(0, 1), b2 + hstep, voffB); PG8_STAGE(PG8_SA(0, 0), a2, voffA);
            PG8_WAIT_V(8); PG8_WAIT_L(0); PG8_BAR; PG8_MMA(1, 0, At, B0); PG8_MMA(1, 1, At, B1); PG8_BAR; PG8_SCHED;
            PG8_LDB(B0, 1, 0); PG8_LDB(B1, 1, 1); PG8_SCHED; PG8_LDA(At, 1, 0); PG8_STAGE(PG8_SA(0, 1), a2 + hstep, voffA);
            PG8_WAIT_V(8); PG8_WAIT_L(0); PG8_BAR; PG8_MMA(0, 0, At, B0); PG8_MMA(0, 1, At, B1); PG8_BAR; PG8_SCHED;
            PG8_LDA(At, 1, 1); PG8_STAGE(PG8_SB(1, 0), b3, voffB); PG8_STAGE(PG8_SB(1, 1), b3 + hstep, voffB); PG8_STAGE(PG8_SA(1, 0), a3, voffA);
            PG8_WAIT_V(8); PG8_WAIT_L(0); PG8_BAR; PG8_MMA(1, 0, At, B0); PG8_MMA(1, 1, At, B1); PG8_BAR; PG8_SCHED;
            } else {
            PG8_LDB(B0, 0, 0); PG8_SCHED; PG8_LDA(At, 0, 0); PG8_STAGE(PG8_SA(1, 1), a1 + hstep, voffA);
            PG8_WAIT_L(8); PG8_BAR; PG8_WAIT_L(0); PG8_MMA(0, 0, At, B0); PG8_BAR; PG8_SCHED;
            PG8_LDB(B1, 0, 1); PG8_STAGE(PG8_SB(0, 0), b2, voffB);
            PG8_BAR; PG8_WAIT_L(0); PG8_MMA(0, 1, At, B1); PG8_BAR;
            PG8_LDA(At, 0, 1); PG8_STAGE(PG8_SA(0, 0), a2, voffA);
            PG8_BAR; PG8_WAIT_L(0); PG8_MMA(1, 0, At, B0); PG8_BAR; PG8_SCHED;
            PG8_STAGE(PG8_SB(0, 1), b2 + hstep, voffB);
            PG8_WAIT_V(6); PG8_BAR; PG8_MMA(1, 1, At, B1); PG8_BAR;
            PG8_LDB(B0, 1, 0); PG8_SCHED; PG8_LDA(At, 1, 0); PG8_STAGE(PG8_SA(0, 1), a2 + hstep, voffA);
            PG8_WAIT_L(8); PG8_BAR; PG8_WAIT_L(0); PG8_MMA(0, 0, At, B0); PG8_BAR; PG8_SCHED;
            PG8_LDB(B1, 1, 1); PG8_STAGE(PG8_SB(1, 0), b3, voffB);
            PG8_BAR; PG8_WAIT_L(0); PG8_MMA(0, 1, At, B1); PG8_BAR;
            PG8_LDA(At, 1, 1); PG8_STAGE(PG8_SA(1, 0), a3, voffA);
            PG8_BAR; PG8_WAIT_L(0); PG8_MMA(1, 0, At, B0); PG8_BAR; PG8_SCHED;
            PG8_STAGE(PG8_SB(1, 1), b3 + hstep, voffB);
            PG8_WAIT_V(6); PG8_BAR; PG8_MMA(1, 1, At, B1); PG8_BAR;
            }
        }
        if constexpr (ALIGN_EPI) { if (wr == 0) PG8_BAR; }
        if constexpr (!Epi::AFTER_DRAIN) { E(acc, cur, wr, wc, fr, fq); S.done(cur); }
        if (!has_next) break;
#pragma unroll
        for (int a = 0; a < 2; ++a)
#pragma unroll
            for (int b = 0; b < 2; ++b)
#pragma unroll
                for (int m = 0; m < 4; ++m)
#pragma unroll
                    for (int n = 0; n < 2; ++n) acc[a][b][m][n] = (f32x4){0.f, 0.f, 0.f, 0.f};
        cur = nxt; cA = nA; cB = nB; ++ui;
        if constexpr (ALIGN_EPI) { if (wr == 1) PG8_BAR; }
    }
    PG8_WAIT_V(0);
    if constexpr (!ALIGN_EPI) { if (wr == 0) PG8_BAR; }
    PG8_BAR;
    if constexpr (Epi::AFTER_DRAIN) { E.fused(acc, cur, wr, wc, fr, fq, lds, wid, lane); S.done(cur); }
#undef PG8_SA
#undef PG8_SB
#undef PG8_STAGE
#undef PG8_LDA
#undef PG8_LDB
#undef PG8_MMA
#undef PG8_WAIT_V
#undef PG8_WAIT_L
#undef PG8_BAR
#undef PG8_SCHED
}
}
namespace att {
typedef unsigned short bf16;
using bf16x8 = __attribute__((ext_vector_type(8))) short;
using s16x4  = __attribute__((ext_vector_type(4))) short;
using f32x16 = __attribute__((ext_vector_type(16))) float;
using u32x4  = __attribute__((ext_vector_type(4))) unsigned;
constexpr int NW = 8, QBLK = 32, KVBLK = 64;
constexpr int SHM_V = KVBLK * 128 * 2, SHM_K = KVBLK * 128 * 2, SHM_WS = 2 * SHM_V + 2 * SHM_K, SHM_Q = SHM_WS + NW * 64 * 4, SHM_ATTN = SHM_Q + NW * 8192;
constexpr float THR = 8.f;
#ifndef ATT_NQREG
#define ATT_NQREG 2
#endif
constexpr int NQREG = ATT_NQREG;
constexpr float LOG2E = 1.4426950408889634f;
#define KSWZ(row, colB) ((row) * 256 + ((colB) ^ (((row) & 7) << 4)))
#define SBAR() __builtin_amdgcn_sched_barrier(0)
__device__ __forceinline__ int crow(int r, int hi) { return (r & 3) + 8 * (r >> 2) + 4 * hi; }
__device__ __forceinline__ unsigned cvtpk(float lo, float hi) { unsigned r; asm volatile("v_cvt_pk_bf16_f32 %0, %1, %2" : "=v"(r) : "v"(lo), "v"(hi)); return r; }
template <int ND0> struct Sc { static constexpr float SCALE = (ND0 == 8) ? 0.088388347648318440f : 0.125f; };

template <int ND0>
__device__ __forceinline__ void partialSM(f32x16& p0, f32x16& p1, float& m_reg, float& mn, float& alpha) {
  constexpr float SCALE = Sc<ND0>::SCALE, C = SCALE * LOG2E;
  float pmax = p0[0];
#pragma unroll
  for (int r = 1; r < 16; ++r) pmax = fmaxf(pmax, p0[r]);
#pragma unroll
  for (int r = 0; r < 16; ++r) pmax = fmaxf(pmax, p1[r]);
  { auto rr = __builtin_amdgcn_permlane32_swap(__float_as_uint(pmax), __float_as_uint(pmax), false, false);
    pmax = fmaxf(__uint_as_float(rr[0]), __uint_as_float(rr[1])); }
  if (__builtin_expect(__all(pmax - m_reg <= THR / SCALE), 1)) { mn = m_reg; alpha = 1.f; }
  else { mn = fmaxf(m_reg, pmax); alpha = __builtin_amdgcn_exp2f((m_reg - mn) * C); m_reg = mn; }
  float mnC = -mn * C;
#pragma unroll
  for (int r = 0; r < 16; ++r) p0[r] = fmaf(p0[r], C, mnC);
#pragma unroll
  for (int r = 0; r < 16; ++r) p1[r] = fmaf(p1[r], C, mnC);
#pragma unroll
  for (int r = 0; r < 16; ++r) p0[r] = __builtin_amdgcn_exp2f(p0[r]);
}
__device__ __forceinline__ void finishSM(f32x16& p0, f32x16& p1, float alpha, float& l_reg, bf16x8& pa0, bf16x8& pa1, bf16x8& pa2, bf16x8& pa3) {
#pragma unroll
  for (int r = 0; r < 16; ++r) p1[r] = __builtin_amdgcn_exp2f(p1[r]);
  float ps = 0;
#pragma unroll
  for (int r = 0; r < 16; ++r) ps += p0[r];
#pragma unroll
  for (int r = 0; r < 16; ++r) ps += p1[r];
  { auto rr = __builtin_amdgcn_permlane32_swap(__float_as_uint(ps), __float_as_uint(ps), false, false);
    ps = __uint_as_float(rr[0]) + __uint_as_float(rr[1]); }
  l_reg = l_reg * alpha + ps;
#define PK4(P, BASE, OUT) do { unsigned a0 = cvtpk(P[BASE + 0], P[BASE + 1]), a1 = cvtpk(P[BASE + 2], P[BASE + 3]);   \
    unsigned b0 = cvtpk(P[BASE + 4], P[BASE + 5]), b1 = cvtpk(P[BASE + 6], P[BASE + 7]);                              \
    auto r0 = __builtin_amdgcn_permlane32_swap(a0, b0, false, false); auto r1 = __builtin_amdgcn_permlane32_swap(a1, b1, false, false); \
    u32x4 w = {r0[0], r1[0], r0[1], r1[1]}; OUT = *reinterpret_cast<bf16x8*>(&w); } while (0)
  PK4(p0, 0, pa0); PK4(p0, 8, pa1); PK4(p1, 0, pa2); PK4(p1, 8, pa3);
#undef PK4
}
template <int ND0>
__device__ __forceinline__ void qkt(f32x16& p0, f32x16& p1, const bf16* Ks, const char* qpark, const bf16x8* qreg, int r32, int hi, int koffB) {
  p0 = f32x16{}; p1 = f32x16{};
#pragma unroll
  for (int d0 = 0; d0 < ND0; ++d0) { int cb = (d0 * 16 + hi * 8) * 2 + koffB;
    bf16x8 b0 = *reinterpret_cast<const bf16x8*>((const char*)Ks + KSWZ(r32, cb));
    bf16x8 b1 = *reinterpret_cast<const bf16x8*>((const char*)Ks + KSWZ(32 + r32, cb));
    const bf16x8 q = (d0 < NQREG) ? qreg[d0 < NQREG ? d0 : 0] : *reinterpret_cast<const bf16x8*>(qpark + d0 * 1024);
    p0 = __builtin_amdgcn_mfma_f32_32x32x16_bf16(b0, q, p0, 0, 0, 0);
    p1 = __builtin_amdgcn_mfma_f32_32x32x16_bf16(b1, q, p1, 0, 0, 0); }
}
__device__ __forceinline__ void wmask(f32x16& p0, f32x16& p1, int kbase, int qpos, int hi) {
  const int d = kbase + 4 * hi - qpos;
#pragma unroll
  for (int r = 0; r < 16; ++r) { const int dk = d + (r & 3) + 8 * (r >> 2);
    if (dk > 128 || dk < -128) p0[r] = -INFINITY;
    if (dk + 32 > 128 || dk + 32 < -128) p1[r] = -INFINITY; }
}
__device__ __forceinline__ int v_st(int k, int c) { const int kk = (k & ~0xC) | ((k & 4) << 1) | ((k & 8) >> 1); return ((kk >> 3) * 4 + (c >> 5)) * 512 + ((kk & 7) * 32 + (c & 31)) * 2; }
__device__ __forceinline__ int v_rd_base(int lane) { return ((lane & 3) << 3) | (((lane >> 2) & 3) << 6) | (((lane >> 4) & 1) << 5) | (((lane >> 5) & 1) << 8); }
constexpr int v_rd_off(int d0, int ks, int half) { return d0 * 512 + ks * 4096 + half * 2048; }
template <int OFF> __device__ __forceinline__ s16x4 tr_read(int vb) {
  s16x4 r; asm volatile("ds_read_b64_tr_b16 %0, %1 offset:%2" : "=&v"(r) : "v"(vb), "i"(OFF) : "memory"); return r;
}
template <int D0> __device__ __forceinline__ void pv_one(f32x16& od, int vb, bf16x8 pa0, bf16x8 pa1, bf16x8 pa2, bf16x8 pa3) {
  const s16x4 l0 = tr_read<v_rd_off(D0, 0, 0)>(vb), h0 = tr_read<v_rd_off(D0, 0, 1)>(vb), l1 = tr_read<v_rd_off(D0, 1, 0)>(vb), h1 = tr_read<v_rd_off(D0, 1, 1)>(vb);
  const s16x4 l2 = tr_read<v_rd_off(D0, 2, 0)>(vb), h2 = tr_read<v_rd_off(D0, 2, 1)>(vb), l3 = tr_read<v_rd_off(D0, 3, 0)>(vb), h3 = tr_read<v_rd_off(D0, 3, 1)>(vb);
  asm volatile("s_waitcnt lgkmcnt(0)" ::: "memory"); SBAR();
#define PK(L, H) (bf16x8){L[0], L[1], L[2], L[3], H[0], H[1], H[2], H[3]}
  od = __builtin_amdgcn_mfma_f32_32x32x16_bf16(pa0, PK(l0, h0), od, 0, 0, 0);
  od = __builtin_amdgcn_mfma_f32_32x32x16_bf16(pa1, PK(l1, h1), od, 0, 0, 0);
  od = __builtin_amdgcn_mfma_f32_32x32x16_bf16(pa2, PK(l2, h2), od, 0, 0, 0);
  od = __builtin_amdgcn_mfma_f32_32x32x16_bf16(pa3, PK(l3, h3), od, 0, 0, 0);
#undef PK
}
__device__ __forceinline__ void pv_d0(f32x16* o, int vb, bf16x8 pa0, bf16x8 pa1, bf16x8 pa2, bf16x8 pa3) {
  pv_one<0>(o[0], vb, pa0, pa1, pa2, pa3); pv_one<1>(o[1], vb, pa0, pa1, pa2, pa3); pv_one<2>(o[2], vb, pa0, pa1, pa2, pa3); pv_one<3>(o[3], vb, pa0, pa1, pa2, pa3);
}

struct AttnUnit {
  const bf16* Q; int ldq;
  const bf16 *K0, *V0; int ld0, n0;
  const bf16 *K1, *V1; int ld1, n1;
  int koffB;
  int win, qpos0, kpos1;
  int has_sink; float sink;
  int pair;
  bf16* O; int ldo;
  float lam, post; const float* gsub;
};

template <int ND0>
__device__ __forceinline__ void attn_body(const AttnUnit& a, char* lds) {
  constexpr float SCALE = Sc<ND0>::SCALE, C = SCALE * LOG2E;
  int tid_ = threadIdx.x; asm volatile("" : "+v"(tid_));
  const int tid = tid_, wid = __builtin_amdgcn_readfirstlane(tid >> 6), lane = tid & 63, r32 = lane & 31, hi = lane >> 5;
  const int half = (ND0 == 4 && a.pair) ? (wid >> 2) : 0, wrow = (ND0 == 4 && a.pair) ? (wid & 3) : wid;
  const int koffB = a.koffB + half * 128;
  bf16* V_lds = (bf16*)lds; bf16* K_lds = (bf16*)(lds + 2 * SHM_V);
  float* ws = (float*)(lds + SHM_WS) + wid * 64; float* li_l = ws; float* al_l = ws + 32;
  float m_reg = -1e30f, l_reg = 0; f32x16 o[4] = {};
  char* qpark = lds + SHM_Q + wid * 8192 + lane * 16;
  __syncthreads();
  const bf16* Qw = a.Q + (size_t)(wrow * QBLK + r32) * a.ldq + hi * 8 + half * 64;
#pragma unroll
  for (int d0 = 0; d0 < ND0; ++d0) *reinterpret_cast<bf16x8*>(qpark + d0 * 1024) = *reinterpret_cast<const bf16x8*>(Qw + d0 * 16);
  bf16x8 qreg[NQREG];
#pragma unroll
  for (int d0 = 0; d0 < NQREG; ++d0) qreg[d0] = *reinterpret_cast<const bf16x8*>(Qw + d0 * 16);
  const int sr = tid >> 4, sc = (tid & 15) * 8, vst0 = v_st(sr, sc), vst1 = v_st(32 + sr, sc);
  const int vb0 = (int)(uintptr_t)V_lds + v_rd_base(lane);
  const int n0 = a.n0, NT = a.n0 + a.n1;
  const int qpos = a.qpos0 + wid * QBLK + r32, qw0 = a.qpos0 + wid * QBLK;
  struct { bf16x8 vs0, vs1, ks0, ks1; } sr_[2];
#define SLOAD(i, jt) do { const int jt_ = (jt); const bool s0_ = jt_ < n0; const int ld_ = s0_ ? a.ld0 : a.ld1; \
    const bf16* kp_ = s0_ ? a.K0 + (size_t)jt_ * KVBLK * a.ld0 : a.K1 + (size_t)(jt_ - n0) * KVBLK * a.ld1;   \
    const bf16* vp_ = s0_ ? a.V0 + (size_t)jt_ * KVBLK * a.ld0 : a.V1 + (size_t)(jt_ - n0) * KVBLK * a.ld1;   \
    sr_[i].vs0 = *reinterpret_cast<const bf16x8*>(vp_ + (size_t)sr * ld_ + sc); sr_[i].vs1 = *reinterpret_cast<const bf16x8*>(vp_ + (size_t)(32 + sr) * ld_ + sc); \
    sr_[i].ks0 = *reinterpret_cast<const bf16x8*>(kp_ + (size_t)sr * ld_ + sc); sr_[i].ks1 = *reinterpret_cast<const bf16x8*>(kp_ + (size_t)(32 + sr) * ld_ + sc); } while (0)
#define SWRITE(b, i) do { *(bf16x8*)((char*)V_lds + (b) * SHM_V + vst0) = sr_[i].vs0;          \
    *(bf16x8*)((char*)V_lds + (b) * SHM_V + vst1) = sr_[i].vs1; int kc = sc * 2;               \
    *(bf16x8*)((char*)K_lds + (b) * SHM_K + KSWZ(sr, kc)) = sr_[i].ks0;                       \
    *(bf16x8*)((char*)K_lds + (b) * SHM_K + KSWZ(32 + sr, kc)) = sr_[i].ks1; } while (0)
#define SWAIT() asm volatile("s_waitcnt vmcnt(4)" ::: "memory")
#define RESC(al) do { if (__any((al) < 1.f)) { if (hi == 0) al_l[r32] = (al); asm volatile("s_waitcnt lgkmcnt(0)" ::: "memory"); \
    _Pragma("unroll") for (int d = 0; d < 4; ++d) _Pragma("unroll") for (int r = 0; r < 16; ++r) o[d][r] *= al_l[crow(r, hi)]; } } while (0)
#define WMASK(P0, P1, jt) do { if (a.win) { const int jt_ = (jt); if (jt_ >= n0) { const int kb_ = a.kpos1 + (jt_ - n0) * KVBLK; \
    if (kb_ + 63 - qw0 > 128 || qw0 + 31 - kb_ > 128) wmask(P0, P1, kb_, qpos, hi); } } } while (0)
  f32x16 pA0, pA1, pB0, pB1; float mnA, mnB, alA, alB; bf16x8 pa0, pa1, pa2, pa3;
  constexpr int SE = 0, SO = 1;
  SLOAD(SE, 0); asm volatile("s_waitcnt vmcnt(0)" ::: "memory"); SWRITE(0, SE); __syncthreads();
  qkt<ND0>(pA0, pA1, K_lds, qpark, qreg, r32, hi, koffB); WMASK(pA0, pA1, 0); partialSM<ND0>(pA0, pA1, m_reg, mnA, alA);
  SLOAD(SO, 1); if (2 < NT) SLOAD(SE, 2);
  SWAIT(); SWRITE(1, SO); __syncthreads();
  for (int j = 1; j + 1 < NT; j += 2) {
    SBAR(); qkt<ND0>(pB0, pB1, (bf16*)((char*)K_lds + SHM_K), qpark, qreg, r32, hi, koffB);
    finishSM(pA0, pA1, alA, l_reg, pa0, pa1, pa2, pa3); SBAR();
    SLOAD(SO, j + 2); SBAR();
    pv_d0(o, vb0, pa0, pa1, pa2, pa3); WMASK(pB0, pB1, j); partialSM<ND0>(pB0, pB1, m_reg, mnB, alB);
    __syncthreads(); SWAIT(); SWRITE(0, SE);
    RESC(alB); __syncthreads();
    SBAR(); qkt<ND0>(pA0, pA1, K_lds, qpark, qreg, r32, hi, koffB);
    finishSM(pB0, pB1, alB, l_reg, pa0, pa1, pa2, pa3); SBAR();
    if (j + 3 < NT) SLOAD(SE, j + 3); SBAR();
    pv_d0(o, vb0 + (int)SHM_V, pa0, pa1, pa2, pa3); WMASK(pA0, pA1, j + 1); partialSM<ND0>(pA0, pA1, m_reg, mnA, alA);
    __syncthreads(); SWAIT(); SWRITE(1, SO);
    RESC(alA); __syncthreads();
  }
  SBAR(); qkt<ND0>(pB0, pB1, (bf16*)((char*)K_lds + SHM_K), qpark, qreg, r32, hi, koffB);
  finishSM(pA0, pA1, alA, l_reg, pa0, pa1, pa2, pa3); SBAR();
  pv_d0(o, vb0, pa0, pa1, pa2, pa3); WMASK(pB0, pB1, NT - 1); partialSM<ND0>(pB0, pB1, m_reg, mnB, alB);
  __syncthreads(); RESC(alB);
  finishSM(pB0, pB1, alB, l_reg, pa0, pa1, pa2, pa3); SBAR();
  pv_d0(o, vb0 + (int)SHM_V, pa0, pa1, pa2, pa3);
  float l_tot = l_reg;
  if (a.has_sink) l_tot += __builtin_amdgcn_exp2f(a.sink * LOG2E - m_reg * C);
  if (hi == 0) li_l[r32] = l_tot; asm volatile("s_waitcnt lgkmcnt(0)" ::: "memory");
  float rli[16];
#pragma unroll
  for (int r = 0; r < 16; ++r) rli[r] = __builtin_amdgcn_rcpf(li_l[crow(r, hi)]);
  if (!(ND0 == 4 && a.pair)) {
    bf16* Ow = a.O + (size_t)(wid * QBLK) * a.ldo;
#pragma unroll
    for (int r = 0; r < 16; ++r) { const int orow = crow(r, hi);
#pragma unroll
      for (int d0 = 0; d0 < 4; ++d0) Ow[(size_t)orow * a.ldo + d0 * 32 + r32] = (bf16)(cvtpk(o[d0][r] * rli[r], 0.f) & 0xffffu); }
  } else {
    float* X = (float*)lds + (size_t)wrow * 4096 + lane;
    __syncthreads();
    if (half == 1) {
#pragma unroll
      for (int r = 0; r < 16; ++r)
#pragma unroll
        for (int d0 = 0; d0 < 4; ++d0) X[(r * 4 + d0) * 64] = o[d0][r] * rli[r];
    }
    __syncthreads();
    if (half == 0) {
      bf16* Ow = a.O + (size_t)(wrow * QBLK) * a.ldo;
      float gs[4];
#pragma unroll
      for (int d0 = 0; d0 < 4; ++d0) gs[d0] = a.gsub[d0 * 32 + r32] * a.post;
#pragma unroll
      for (int r = 0; r < 16; ++r) { const int orow = crow(r, hi); float ss = 0.f;
#pragma unroll
        for (int d0 = 0; d0 < 4; ++d0) { const float v = o[d0][r] * rli[r] - a.lam * X[(r * 4 + d0) * 64]; o[d0][r] = v; ss += v * v; }
        ss += xshfl<1>(ss); ss += xshfl<2>(ss); ss += xshfl<4>(ss); ss += xshfl<8>(ss); ss += xshfl<16>(ss);
        const float rn = 1.0f / sqrtf(ss * (1.0f / 128.0f) + 1e-6f);
#pragma unroll
        for (int d0 = 0; d0 < 4; ++d0) Ow[(size_t)orow * a.ldo + d0 * 32 + r32] = (bf16)(cvtpk(o[d0][r] * rn * gs[d0], 0.f) & 0xffffu); }
    }
  }
#undef SLOAD
#undef SWRITE
#undef SWAIT
#undef RESC
#undef WMASK
}
#undef KSWZ
#undef SBAR
}
constexpr int D = 2048, FF = 5632, NIN = 4096, DEPTH = 4, M_CTX = 4096, M_LAT = 4096, M = M_CTX + M_LAT;
constexpr int NWAVES = 8;
constexpr float EPS = 1e-6f;
constexpr size_t OFF_AK = 16777216, OFF_AV = 20971520, OFF_BK = 25165824, OFF_BV = 33554432, OFF_CK = 41943040, OFF_CV = 46137344, OUT_TOTAL = 50331648;
constexpr size_t MiB = 1u << 20;
constexpr size_t WS_CTL = 0, CTL_ZERO_BYTES = 1 * MiB;
constexpr size_t WS_MOD = 1 * MiB;
constexpr size_t WS_ROPE = 2 * MiB;
constexpr size_t WS_CACHE = 4 * MiB;
constexpr size_t WS_WGU = 20 * MiB;
constexpr size_t WS_WD = WS_WGU + 8 * 44 * MiB;
constexpr size_t WS_WIN = WS_WD + 8 * 22 * MiB;
constexpr size_t WS_WOUT = WS_WIN + 4 * 16 * MiB;
constexpr size_t WS_H = WS_WOUT + 4 * 8 * MiB;
constexpr size_t WS_ACT = WS_H + 32 * MiB;
constexpr size_t WS_Y = WS_ACT + 88 * MiB;
constexpr size_t WS_P = WS_Y + 64 * MiB;
constexpr size_t WS_O = WS_P + 64 * MiB;
constexpr size_t WS_XB = WS_O + 32 * MiB;
constexpr size_t WS_END = WS_XB + 32 * MiB;
constexpr int CW_TMO = 0, CW_BAR = 4096, CW_Q = 16384;
constexpr int RING_OFF = 0, RING_BYTES = 135168, LDSCTL_OFF = RING_BYTES, MISC_OFF = LDSCTL_OFF + 320, NORM_OFF = LDSCTL_OFF + 2048  , LDS_BYTES = 147456;
static_assert(NORM_OFF + 8192 <= LDS_BYTES, "LDS map");

#define GAS __attribute__((address_space(1)))
#define LAS __attribute__((address_space(3)))
typedef unsigned short bf16;
typedef unsigned v4u __attribute__((ext_vector_type(4)));
typedef unsigned v2u __attribute__((ext_vector_type(2)));
typedef float f32x4 __attribute__((ext_vector_type(4)));
typedef GAS unsigned gu32;
#define RLX_AGENT __ATOMIC_RELAXED, __HIP_MEMORY_SCOPE_AGENT
__device__ __forceinline__ unsigned f2bf(float f) { unsigned u = __builtin_bit_cast(unsigned, f); return (u + 0x7fffu + ((u >> 16) & 1u)) >> 16; }
__device__ __forceinline__ unsigned pk2(float lo, float hi) { return f2bf(lo) | (f2bf(hi) << 16); }
__device__ __forceinline__ float bflo(unsigned w) { return __builtin_bit_cast(float, w << 16); }
__device__ __forceinline__ float bfhi(unsigned w) { return __builtin_bit_cast(float, w & 0xffff0000u); }
#define XB_TMO      128
#define XB_XCNT(j)  (256  + 64 * (j))
#define XB_XSUB(j)  (1280 + 64 * (j))
#define XB_XGEN(j)  (2304 + 64 * (j))
#define XB_TOP      3328
#define XB_TOPGEN   3392
#define XCD_BAR_WORDS 3456
#define XB_SPIN_CAP (1u << 18)

__device__ __forceinline__ unsigned xb_ld(unsigned* p)              { return __hip_atomic_load(p, __ATOMIC_RELAXED, __HIP_MEMORY_SCOPE_AGENT); }
__device__ __forceinline__ unsigned xb_add(unsigned* p, unsigned v) { return __hip_atomic_fetch_add(p, v, __ATOMIC_RELAXED, __HIP_MEMORY_SCOPE_AGENT); }
__device__ __forceinline__ unsigned xb_xcc_id() { return (unsigned)__builtin_amdgcn_s_getreg((3 << 11) | 20) & 0xFu; }
#define XB_SPIN(cond, bar) do { unsigned _sp = 0; while (cond) { __builtin_amdgcn_s_sleep(1); \
    if ((++_sp & 255u) == 0u) { if (xb_ld(&(bar)[XB_TMO])) break; if (_sp > XB_SPIN_CAP) { atomicAdd(&(bar)[XB_TMO], 1u); break; } } } } while (0)

struct XcdBarrier {
    unsigned* bar; unsigned x;
    volatile LAS unsigned* st;
};

__device__ __forceinline__ XcdBarrier xcd_barrier_post(unsigned* bar, volatile LAS unsigned* st) {
    XcdBarrier b; b.bar = bar; b.x = xb_xcc_id(); b.st = st;
    if (threadIdx.x == 0) (void)xb_add(&bar[XB_XCNT(b.x)], 1u);
    return b;
}
__device__ __forceinline__ void xcd_barrier_complete(unsigned* bar, unsigned x, unsigned& nloc, unsigned& nx) {
    const unsigned G = gridDim.x * gridDim.y * gridDim.z;
    unsigned sum, cnt, mine, sp = 0u;
    for (;;) {
        sum = 0u; cnt = 0u; mine = 0u;
#pragma unroll
        for (unsigned j = 0; j < 16; ++j) { const unsigned c = xb_ld(&bar[XB_XCNT(j)]); sum += c; cnt += (c > 0u) ? 1u : 0u; mine = (j == x) ? c : mine; }
        if (sum == G) break;
        __builtin_amdgcn_s_sleep(1);
        if ((++sp & 255u) == 0u) { if (xb_ld(&bar[XB_TMO])) break; if (sp > XB_SPIN_CAP) { atomicAdd(&bar[XB_TMO], 1u); break; } }
    }
    nloc = mine > 0u ? mine : 1u; nx = cnt > 0u ? cnt : 1u;
}

__device__ __forceinline__ void xcd_barrier(const XcdBarrier& b) {
    asm volatile("s_waitcnt vmcnt(0)" ::: "memory");
    __syncthreads();
    if (threadIdx.x == 0) {
        unsigned* bar = b.bar; unsigned bx = b.x; asm volatile("" : "+s"(bar), "+s"(bx));
        __builtin_amdgcn_s_waitcnt(0);
        unsigned nloc = b.st[0], nx = b.st[1];
        if (nloc == 0u) { xcd_barrier_complete(bar, bx, nloc, nx); b.st[0] = nloc; b.st[1] = nx; }
        const unsigned old = xb_add(&bar[XB_XSUB(bx)], 1u);
        const unsigned gen = old / nloc;
        if (old + 1u == (gen + 1u) * nloc) {
            __builtin_amdgcn_fence(__ATOMIC_RELEASE, "agent");
            asm volatile("s_waitcnt vmcnt(0)" ::: "memory");
            const unsigned og = xb_add(&bar[XB_TOP], 1u);
            const unsigned tg = og / nx;
            if (og + 1u == (tg + 1u) * nx) xb_add(&bar[XB_TOPGEN], 1u);
            else XB_SPIN(xb_ld(&bar[XB_TOPGEN]) == tg, bar);
            __builtin_amdgcn_fence(__ATOMIC_ACQUIRE, "agent");
            xb_add(&bar[XB_XGEN(bx)], 1u);
            asm volatile("s_waitcnt vmcnt(0)" ::: "memory");
        } else {
            XB_SPIN(xb_ld(&bar[XB_XGEN(bx)]) == gen, bar);
            __builtin_amdgcn_fence(__ATOMIC_ACQUIRE, "agent");
            asm volatile("s_waitcnt vmcnt(0)" ::: "memory");
        }
    }
    __syncthreads();
}
struct Args { const float* in[24]; float* out; unsigned char* ws; int ph_lo, ph_hi; };
#define PHASE_IDS() const int tid = opq_tid(), lane = tid & 63, wave = __builtin_amdgcn_readfirstlane(tid >> 6), G = (int)gridDim.x, gw = (int)blockIdx.x * NWAVES + wave, NGW = G * NWAVES; (void)lane; (void)gw; (void)NGW; (void)G
enum { I_XP = 0, I_XS, I_CAK, I_CAV, I_CBK, I_CBV, I_CCK, I_CCV, I_C, I_CCTX, I_WMOD, I_BMOD, I_NPRE, I_NPOST, I_FG, I_FU, I_FD, I_WIN, I_WOUT, I_SINK, I_LAM, I_SUBLN, I_QN, I_KN };

__device__ __forceinline__ int cond_of_row(int m) { return m < M_CTX ? 0 : 1 + ((m - M_CTX) >> 11); }
__device__ __forceinline__ const float* mod_vec(const Args& A, int l, int cond, int k) { return (const float*)(A.ws + WS_MOD) + ((size_t)(l * 3 + cond) * 9 + k) * D; }

__device__ __forceinline__ void tr_item(const float* W, int N, int K, int k0, int n0, bf16* WT, size_t drow0, int lane) {
    const int c = lane & 7, nn = lane >> 3;
    const float* src = W + (size_t)(k0 + 8 * c) * N + n0 + 4 * nn;
    f32x4 v[8];
#pragma unroll
    for (int i = 0; i < 8; ++i) v[i] = *(const f32x4*)(src + (size_t)i * N);
#pragma unroll
    for (int j = 0; j < 4; ++j) {
        v4u w; w.x = pk2(v[0][j], v[1][j]); w.y = pk2(v[2][j], v[3][j]); w.z = pk2(v[4][j], v[5][j]); w.w = pk2(v[6][j], v[7][j]);
        *(v4u*)(WT + (drow0 + 4 * nn + j) * (size_t)K + k0 + 8 * c) = w;
    }
}

constexpr int PER_L = 2 * 3 * 5632 + 4096 + 2048;
#ifndef CONV_TAIL
#define CONV_TAIL 6144
#endif
constexpr int CONV_TAIL_X = CONV_TAIL;
struct TrJob { const float* src; bf16* dst; int N, K, rs; };
__device__ __forceinline__ TrJob tr_decode(const Args& A, int l, int r, int lane) {
    const float* W; bf16* WT; int N, K, k0, n0, rs = 1; size_t drow0;
    if (r < 33792) { const int s = r / 16896, r2 = r % 16896, which = r2 / 5632, r3 = r2 % 5632;
        if (which < 2) { const int kb = r3 / 176, nb = r3 % 176; n0 = 32 * nb; k0 = 64 * kb; N = FF; K = D;
            W = A.in[which == 0 ? I_FG : I_FU] + (size_t)(l * 2 + s) * D * FF; WT = (bf16*)(A.ws + WS_WGU) + (size_t)(l * 2 + s) * 11264 * D;
            drow0 = (size_t)(n0 >> 7) * 256 + which * 128 + (n0 & 127);
        } else { const int kb = r3 / 64, nb = r3 % 64; n0 = 32 * nb; k0 = 64 * kb; N = D; K = FF;
            W = A.in[I_FD] + (size_t)(l * 2 + s) * FF * D; WT = (bf16*)(A.ws + WS_WD) + (size_t)(l * 2 + s) * D * FF; drow0 = (size_t)n0; }
    } else { r -= 33792;
        if (r < 4096) { const int kb = r / 128, nb = r % 128; n0 = 32 * nb; k0 = 64 * kb; N = NIN; K = D; W = A.in[I_WIN] + (size_t)l * D * NIN; WT = (bf16*)(A.ws + WS_WIN) + (size_t)l * NIN * D; drow0 = (size_t)n0;
            const bool g128 = n0 < 1024 || (n0 >= 2816 && n0 < 3840), g64 = n0 >= 1280 && n0 < 2304;
            if (g128) { const int i0 = n0 & 127; drow0 = (size_t)(n0 - i0) + 2 * (i0 & 63) + (i0 >> 6); rs = 2; }
            else if (g64) { const int i0 = n0 & 63; drow0 = (size_t)(n0 - i0) + 2 * (i0 & 31) + (i0 >> 5); rs = 2; }
        } else { r -= 4096; const int kb = r / 64, nb = r % 64; n0 = 32 * nb; k0 = 64 * kb; N = D; K = D; W = A.in[I_WOUT] + (size_t)l * D * D; WT = (bf16*)(A.ws + WS_WOUT) + (size_t)l * D * D; drow0 = (size_t)n0; }
    }
    const int c = lane & 7, nn = lane >> 3;
    TrJob j; j.src = W + (size_t)(k0 + 8 * c) * N + n0 + 4 * nn; j.dst = WT + (drow0 + (size_t)(4 * nn) * rs) * (size_t)K + k0 + 8 * c; j.N = N; j.K = K; j.rs = rs; return j;
}
__device__ __forceinline__ void convert_items(const Args& A, int l, int lo, int hi, int w, int nw, int lane) {
    int r = lo + w; if (r >= hi) return;
    TrJob j = tr_decode(A, l, r, lane); f32x4 v[8];
#pragma unroll
    for (int i = 0; i < 8; ++i) v[i] = __builtin_nontemporal_load((const f32x4*)(j.src + (size_t)i * j.N));
    for (;;) {
        const int rn = r + nw; const bool more = rn < hi;
        TrJob jn = j; f32x4 vn[8];
        if (more) { jn = tr_decode(A, l, rn, lane);
#pragma unroll
            for (int i = 0; i < 8; ++i) vn[i] = __builtin_nontemporal_load((const f32x4*)(jn.src + (size_t)i * jn.N)); }
#pragma unroll
        for (int q = 0; q < 4; ++q) { v4u o; o.x = pk2(v[0][q], v[1][q]); o.y = pk2(v[2][q], v[3][q]); o.z = pk2(v[4][q], v[5][q]); o.w = pk2(v[6][q], v[7][q]);
            *(v4u*)(j.dst + (size_t)(q * j.rs) * j.K) = o; }
        if (!more) break;
        r = rn; j = jn;
#pragma unroll
        for (int i = 0; i < 8; ++i) v[i] = vn[i];
    }
}
__device__ __forceinline__ void p0a(const Args& A_, LAS unsigned char* lds) {
    PHASE_IDS(); Args A = A_; A.ws = opq(A_.ws);
    {
        LAS float* sil = (LAS float*)lds; LAS float* red = (LAS float*)(lds + 24576);
        for (int i = tid; i < 3 * D; i += NWAVES * 64) { const int cc = i / D, k = i % D; const float x = cc == 0 ? A.in[I_CCTX][k] : A.in[I_C][(cc - 1) * D + k]; sil[i] = x / (1.0f + expf(-x)); }
        __syncthreads();
        const int kc = tid >> 5, c4 = tid & 31;
        for (int task = blockIdx.x; task < DEPTH * 144; task += G) {
            const int l = task / 144, cb = task % 144;
            const float* w = A.in[I_WMOD] + ((size_t)l * D + kc * 128) * 18432 + cb * 128 + c4 * 4;
            f32x4 a0 = {0.f, 0.f, 0.f, 0.f}, a1 = a0, a2 = a0;
            for (int kk = 0; kk < 128; kk += 8) {
                f32x4 wv[8];
#pragma unroll
                for (int i = 0; i < 8; ++i) wv[i] = *(const f32x4*)(w + (size_t)(kk + i) * 18432);
#pragma unroll
                for (int i = 0; i < 8; ++i) { const int k = kc * 128 + kk + i; a0 += wv[i] * sil[k]; a1 += wv[i] * sil[D + k]; a2 += wv[i] * sil[2 * D + k]; }
            }
            LAS float* rp = red + (kc * 32 + c4) * 12;
#pragma unroll
            for (int i = 0; i < 4; ++i) { rp[i] = a0[i]; rp[4 + i] = a1[i]; rp[8 + i] = a2[i]; }
            __syncthreads();
            if (tid < 384) { const int cc = tid >> 7, col = tid & 127; float s = 0.f;
#pragma unroll
                for (int q = 0; q < 16; ++q) s += red[(q * 32 + (col >> 2)) * 12 + cc * 4 + (col & 3)];
                ((float*)(A.ws + WS_MOD))[(size_t)(l * 3 + cc) * 18432 + cb * 128 + col] = s + A.in[I_BMOD][l * 18432 + cb * 128 + col]; }
            __syncthreads();
        }
    }
    convert_items(A, 0, 0, 11264, gw, NGW, lane);
    const int gt = blockIdx.x * (NWAVES * 64) + tid, NGT = G * NWAVES * 64;
    for (int i = gt; i < DEPTH * 2 * 512 * 256; i += NGT) {
        const int col = (i & 255) * 8, pos = (i >> 8) & 511, b = (i >> 17) & 1, l = i >> 18;
        const size_t rb = (size_t)(b * DEPTH + l) * 512 + pos;
        const float* src;
        if (col < 256) src = A.in[I_CAK] + rb * 256 + col; else if (col < 512) src = A.in[I_CAV] + rb * 256 + (col - 256);
        else if (col < 1024) src = A.in[I_CBK] + rb * 512 + (col - 512); else if (col < 1536) src = A.in[I_CBV] + rb * 512 + (col - 1024);
        else if (col < 1792) src = A.in[I_CCK] + rb * 256 + (col - 1536); else src = A.in[I_CCV] + rb * 256 + (col - 1792);
        const int grp = (col < 256 || (col >= 1536 && col < 1792)) ? 128 : ((col >= 512 && col < 1024) ? 64 : 0);
        f32x4 x0, x1;
        if (grp == 0) { x0 = *(const f32x4*)src; x1 = *(const f32x4*)(src + 4); }
        else { const int pg = col & (grp - 1); const float* sg = src - pg + (pg >> 1);
            const f32x4 lo = *(const f32x4*)sg, hi = *(const f32x4*)(sg + (grp >> 1));
            x0 = (f32x4){lo[0], hi[0], lo[1], hi[1]}; x1 = (f32x4){lo[2], hi[2], lo[3], hi[3]}; }
        v4u w; w.x = pk2(x0[0], x0[1]); w.y = pk2(x0[2], x0[3]); w.z = pk2(x1[0], x1[1]); w.w = pk2(x1[2], x1[3]);
        *(v4u*)((bf16*)(A.ws + WS_CACHE) + ((size_t)(l * 2 + b) * 512 + pos) * 2048 + col) = w;
    }
    {
        float* rp = (float*)(A.ws + WS_ROPE);
        for (int i = gt; i < 2048 * 96; i += NGT) {
            const int t = i / 96, a = i % 96; const float row = (float)(t >> 6), col = (float)(t & 63);
            if (a < 64) { const int f = a & 31; const float inv = powf(10000.0f, -(float)f / 32.0f), ang = (a < 32 ? row : col) * inv;
                rp[t * 64 + a] = cosf(ang); rp[131072 + t * 64 + a] = sinf(ang);
            } else { const int a2 = a - 64, f = a2 & 15; const float inv = powf(10000.0f, -(float)f / 16.0f), ang = (a2 < 16 ? row : col) * inv;
                rp[262144 + t * 32 + a2] = cosf(ang); rp[262144 + 65536 + t * 32 + a2] = sinf(ang); }
        }
    }
}

__device__ __forceinline__ void h_row(const f32x4 (&x)[8], const float* gpre, const float* shift, const float* scale, bf16* hrow, int lane) {
    float ss = 0.f;
#pragma unroll
    for (int j = 0; j < 8; ++j) ss += (x[j][0] * x[j][0] + x[j][1] * x[j][1]) + (x[j][2] * x[j][2] + x[j][3] * x[j][3]);
    const float r = 1.0f / sqrtf(wave_sum(ss) * (1.0f / D) + EPS);
#pragma unroll
    for (int j = 0; j < 8; ++j) { const int o = 256 * j + 4 * lane;
        const f32x4 g = *(const f32x4*)(gpre + o), sh = *(const f32x4*)(shift + o), sc = *(const f32x4*)(scale + o);
        const f32x4 h = (x[j] * r) * g * (sc + 1.0f) + sh;
        v2u w; w.x = pk2(h[0], h[1]); w.y = pk2(h[2], h[3]); *(v2u*)(hrow + o) = w; }
}
__device__ __forceinline__ void t0_phase(const Args& A_) {
    PHASE_IDS(); Args A = A_; A.ws = opq(A_.ws); A.out = opq(A_.out);
    for (int m = gw; m < M; m += NGW) {
        const float* src = m < M_CTX ? A.in[I_XP] + (size_t)m * D : A.in[I_XS] + (size_t)(m - M_CTX) * D;
        f32x4 x[8];
#pragma unroll
        for (int j = 0; j < 8; ++j) x[j] = *(const f32x4*)(src + 256 * j + 4 * lane);
        const int cd = cond_of_row(m);
        h_row(x, A.in[I_NPRE], mod_vec(A, 0, cd, 0), mod_vec(A, 0, cd, 1), (bf16*)(A.ws + WS_H) + (size_t)m * D, lane);
    }
}
template <bool XIN_F32, bool XOUT_F32>
__device__ __forceinline__ void t1_body(const Args& A, int l, int j, LAS unsigned char* lds, int tid, int lane, int wave, int G) {
    const float wgt = (j == 1) ? 1.0f : 0.5f;
    const int nl = (j == 2) ? l + 1 : l, nj = (j == 2) ? 0 : j + 1; const bool has_next = nl < DEPTH;
    const float* gpost = A.in[I_NPOST] + (size_t)(l * 3 + j) * D;
    const float* gpre = A.in[I_NPRE] + (size_t)((has_next ? nl : 0) * 3 + nj) * D;
    LAS f32x4* V0 = (LAS f32x4*)lds; LAS f32x4* V1 = (LAS f32x4*)(lds + 8192); LAS f32x4* V2 = (LAS f32x4*)(lds + 16384);
    const bf16* Yb = (const bf16*)(A.ws + WS_Y); bf16* Hb = (bf16*)(A.ws + WS_H); bf16* Xb = (bf16*)(A.ws + WS_XB);
    typedef typename std::conditional<XIN_F32, f32x4, v2u>::type xraw_t;
    for (int blk = blockIdx.x; blk < M / 32; blk += G) {
        const int mb = blk * 32, cd = cond_of_row(mb);
        {
            const int o = 4 * tid;
            const f32x4 g = *(const f32x4*)(mod_vec(A, l, cd, 3 * j + 2) + o), gp = *(const f32x4*)(gpost + o);
            V0[tid] = (g * wgt) * gp;
            if (has_next) { const f32x4 ge = *(const f32x4*)(gpre + o), sc = *(const f32x4*)(mod_vec(A, nl, cd, 3 * nj + 1) + o), sh = *(const f32x4*)(mod_vec(A, nl, cd, 3 * nj) + o);
                V1[tid] = ge * (sc + 1.0f); V2[tid] = sh; }
        }
        __syncthreads();
        const int m0 = mb + 4 * wave;
        const float* Xsrc = mb < M_CTX ? A.in[I_XP] : A.in[I_XS] - (size_t)M_CTX * D;
        v2u ya[8], yb[8]; xraw_t xa[8], xb[8];
#define T1_LOAD(Y, X, m) do { const bf16* yr_ = Yb + (size_t)(m) * D + 4 * lane; \
        _Pragma("unroll") for (int q = 0; q < 8; ++q) { Y[q] = *(const v2u*)(yr_ + 256 * q); \
            if constexpr (XIN_F32) X[q] = __builtin_nontemporal_load((const xraw_t*)(Xsrc + (size_t)(m) * D + 4 * lane + 256 * q)); \
            else X[q] = __builtin_nontemporal_load((const xraw_t*)(Xb + (size_t)(m) * D + 4 * lane + 256 * q)); } } while (0)
#define T1_PROC(Y, XR, m) do { float ss = 0.f; f32x4 yf[8], X[8]; \
        _Pragma("unroll") for (int q = 0; q < 8; ++q) { yf[q] = (f32x4){bflo(Y[q].x), bfhi(Y[q].x), bflo(Y[q].y), bfhi(Y[q].y)}; \
            ss += (yf[q][0] * yf[q][0] + yf[q][1] * yf[q][1]) + (yf[q][2] * yf[q][2] + yf[q][3] * yf[q][3]); } \
        const float r = 1.0f / sqrtf(wave_sum(ss) * (1.0f / D) + EPS); float s2 = 0.f; \
        _Pragma("unroll") for (int q = 0; q < 8; ++q) { \
            if constexpr (XIN_F32) X[q] = XR[q]; else X[q] = (f32x4){bflo(XR[q].x), bfhi(XR[q].x), bflo(XR[q].y), bfhi(XR[q].y)}; \
            X[q] = X[q] + V0[64 * q + lane] * (yf[q] * r); \
            if constexpr (XOUT_F32) __builtin_nontemporal_store(X[q], (f32x4*)(A.out + (size_t)(m) * D + 4 * lane + 256 * q)); \
            else { v2u w; w.x = pk2(X[q][0], X[q][1]); w.y = pk2(X[q][2], X[q][3]); __builtin_nontemporal_store(w, (v2u*)(Xb + (size_t)(m) * D + 4 * lane + 256 * q)); } \
            s2 += (X[q][0] * X[q][0] + X[q][1] * X[q][1]) + (X[q][2] * X[q][2] + X[q][3] * X[q][3]); } \
        if (has_next) { const float r2 = 1.0f / sqrtf(wave_sum(s2) * (1.0f / D) + EPS); bf16* hw_ = Hb + (size_t)(m) * D + 4 * lane; \
            _Pragma("unroll") for (int q = 0; q < 8; ++q) { const f32x4 h = (X[q] * r2) * V1[64 * q + lane] + V2[64 * q + lane]; \
                v2u w; w.x = pk2(h[0], h[1]); w.y = pk2(h[2], h[3]); st8_wt(hw_ + 256 * q, w); } } } while (0)
        T1_LOAD(ya, xa, m0);
        T1_LOAD(yb, xb, m0 + 1);
        T1_PROC(ya, xa, m0);
        T1_LOAD(ya, xa, m0 + 2);
        T1_PROC(yb, xb, m0 + 1);
        T1_LOAD(yb, xb, m0 + 3);
        T1_PROC(ya, xa, m0 + 2);
        T1_PROC(yb, xb, m0 + 3);
#undef T1_LOAD
#undef T1_PROC
        __syncthreads();
    }
}
__device__ __forceinline__ void t1_phase(const Args& A_, int l, int j, LAS unsigned char* lds) {
    PHASE_IDS(); Args A = A_; A.ws = opq(A_.ws); A.out = opq(A_.out);
    if (l == 0 && j == 0) t1_body<true, false>(A, l, j, lds, tid, lane, wave, G);
    else if (l == DEPTH - 1 && j == 2) t1_body<false, true>(A, l, j, lds, tid, lane, wave, G);
    else t1_body<false, false>(A, l, j, lds, tid, lane, wave, G);
    {
        const int cl = (j == 2) ? l + 1 : l, lo = (j == 0) ? 33792 + CONV_TAIL_X : CONV_TAIL_X, hi = (j == 0) ? PER_L : 11264;
        if (cl < DEPTH && j != 1) convert_items(A, cl, lo, hi, gw, NGW, lane);
    }
}
constexpr int ATT_NUNITS = 640;
static_assert(att::SHM_ATTN <= RING_BYTES && pg8::STAGE_BYTES <= RING_BYTES && MISC_OFF + 128 <= LDS_BYTES, "LDS map");
constexpr int P_QA = 0, P_KA = 768, P_VA = 1024, P_QB = 1280, P_KB = 1792, P_VB = 2304, P_QC = 2816, P_KC = 3584, P_VC = 3840;
constexpr int C_KA = 0, C_VA = 256, C_KB = 512, C_VB = 1024, C_KC = 1536, C_VC = 1792;
constexpr int O_A = 0, O_B = 768, O_C = 1280;
__device__ __forceinline__ void attn_phase(const Args& A_, int l, char* lds, volatile LAS unsigned* MISC) {
    PHASE_IDS(); Args A = A_; A.ws = opq(A_.ws);
    gu32* head = (gu32*)(A.ws + WS_CTL) + CW_Q + 64 * l;
    const bf16* P = (const bf16*)(A.ws + WS_P); bf16* O = (bf16*)(A.ws + WS_O);
    const bf16* CA = (const bf16*)(A.ws + WS_CACHE) + (size_t)l * 2 * 512 * 2048;
    const float lam_init = (l == 0) ? 0.2f : (l == 1) ? 0.35550906759f : (l == 2) ? 0.47071301834f : 0.55605820416f;
    float lam;
    { const float* bl = A.in[I_LAM] + l * 256; const float a = bl[lane] * bl[64 + lane], b = bl[128 + lane] * bl[192 + lane];
      lam = expf(wave_sum(a)) - expf(wave_sum(b)) + lam_init; lam = __builtin_bit_cast(float, __builtin_amdgcn_readfirstlane(__builtin_bit_cast(int, lam))); }
    for (;;) {
        __syncthreads();
        if (tid == 0) MISC[16] = __hip_atomic_fetch_add(head, 1u, RLX_AGENT);
        __syncthreads();
        const int u = __builtin_amdgcn_readfirstlane((int)MISC[16]);
        if (u >= ATT_NUNITS) break;
        int kind, lat, b, qb, h, rows = 256;
        if (u < 96) { const int i = u; kind = 2; lat = 1; b = i / 48; qb = (i / 6) & 7; h = i % 6; }
        else if (u < 224) { const int i = u - 96; kind = 1; lat = 1; rows = 128; b = i >> 6; qb = (i >> 2) & 15; h = i & 3; }
        else if (u < 320) { const int i = u - 224; kind = 0; lat = 1; b = i / 48; qb = (i / 6) & 7; h = i % 6; }
        else if (u < 416) { const int i = u - 320; kind = 0; lat = 0; b = i / 6; qb = 0; h = i % 6; }
        else if (u < 512) { const int i = u - 416; kind = 2; lat = 0; b = i / 6; qb = 0; h = i % 6; }
        else { const int i = u - 512; kind = 1; lat = 0; rows = 128; b = i >> 3; qb = (i >> 2) & 1; h = i & 3; }
        const int kvh = (kind == 1) ? h : h / 3;
        const int qcol = (kind == 0 ? P_QA : kind == 1 ? P_QB : P_QC) + h * 128;
        const int kcol = (kind == 0 ? P_KA : kind == 1 ? P_KB : P_KC) + kvh * 128, vcol = (kind == 0 ? P_VA : kind == 1 ? P_VB : P_VC) + kvh * 128;
        const int ckcol = (kind == 0 ? C_KA : kind == 1 ? C_KB : C_KC) + kvh * 128, cvcol = (kind == 0 ? C_VA : kind == 1 ? C_VB : C_VC) + kvh * 128;
        const int ocol = (kind == 0 ? O_A : kind == 1 ? O_B : O_C) + h * 128;
        const int seq0 = lat ? M_CTX + b * 2048 : b * 256;
        const int m0 = seq0 + qb * rows;
        att::AttnUnit a;
        a.Q = P + (size_t)m0 * NIN + qcol; a.ldq = NIN;
        if (lat) { a.K0 = CA + (size_t)b * 512 * 2048 + ckcol; a.V0 = CA + (size_t)b * 512 * 2048 + cvcol; a.ld0 = 2048; a.n0 = 8; }
        else { a.K0 = P; a.V0 = P; a.ld0 = NIN; a.n0 = 0; }
        int klo = 0, khi = lat ? 2048 : 256;
        a.win = 0;
        if (lat && kind == 0) { klo = qb * 256 - 128; if (klo < 0) klo = 0; khi = qb * 256 + 384; if (khi > 2048) khi = 2048; a.win = 1; }
        a.K1 = P + (size_t)(seq0 + klo) * NIN + kcol; a.V1 = P + (size_t)(seq0 + klo) * NIN + vcol; a.ld1 = NIN; a.n1 = (khi - klo) >> 6;
        a.qpos0 = qb * 256; a.kpos1 = klo; a.koffB = 0;
        a.has_sink = (kind == 0); a.sink = (kind == 0) ? A.in[I_SINK][l * 6 + h] : 0.f;
        a.O = O + (size_t)m0 * D + ocol; a.ldo = D; a.pair = (kind == 1);
        a.lam = lam; a.post = 1.0f - lam_init; a.gsub = A.in[I_SUBLN] + l * 128;
        if (kind != 1) att::attn_body<8>(a, lds); else att::attn_body<4>(a, lds);
    }
    {
        gu32* chead = (gu32*)(A.ws + WS_CTL) + CW_Q + 64 * (DEPTH + l);
        for (;;) {
            unsigned cchunk = 0; if (lane == 0) cchunk = __hip_atomic_fetch_add(chead, 1u, RLX_AGENT);
            const int cc = __builtin_amdgcn_readfirstlane((int)cchunk);
            if (cc >= 11264 / 8) break;
            convert_items(A, l, 16896 + 8 * cc, 16896 + 8 * cc + 8, 0, 1, lane);
        }
    }
}

constexpr int NPH = 2 + DEPTH * 10;
__global__ void __launch_bounds__(NWAVES * 64, 2) fwd(Args args) {
    extern __shared__ __attribute__((aligned(16))) unsigned char lds[];
    LAS unsigned char* L = (LAS unsigned char*)lds;
    volatile LAS unsigned* MISC = (volatile LAS unsigned*)(L + MISC_OFF);
    const Args& A = args;
    for (int u = threadIdx.x; u < (LDS_BYTES - LDSCTL_OFF) / 4; u += NWAVES * 64) ((LAS unsigned*)(L + LDSCTL_OFF))[u] = 0u;
    __syncthreads();
    gu32* ctl = (gu32*)(args.ws + WS_CTL);
    XcdBarrier bar = xcd_barrier_post((unsigned*)(ctl + CW_BAR), MISC + 8);
    const int lo = args.ph_lo, hi = args.ph_hi; int ph = 0;
#define PH_ON() (ph >= lo && ph < hi)
#define PH_END() do { if (ph + 1 < hi) xcd_barrier(bar); } while (0)

    #ifndef NO_P0
    if (PH_ON()) { p0a(A, L); PH_END(); } ++ph;
#endif
    #ifndef NO_T
    if (PH_ON()) { t0_phase(A); PH_END(); } ++ph;
#endif

    for (int sl = 0; sl < 3 * DEPTH; ++sl) {
        const int l = sl / 3, j = sl % 3;
        if (j != 1) {
            const int s = j >> 1;
#ifndef NO_GEMM
            if (PH_ON()) {
                unsigned char* wsq = opq(args.ws);
                pg8::Gemm g{(const pg8::bf16_t*)(wsq + WS_H), (const pg8::bf16_t*)(wsq + WS_WGU) + (size_t)(l * 2 + s) * 11264 * D, M, 11264, D};
                pg8::StaticOrder S; S.init(M, 11264, (int)gridDim.x, (int)blockIdx.x);
                pg8::EpiSwiglu E{(pg8::bf16_t*)(wsq + WS_ACT), FF};
                pg8::gemm_phase<pg8::EpiSwiglu, pg8::StaticOrder, true, true>(L + RING_OFF, g, S, E);
                {
                    const int G_ = (int)gridDim.x, rem = (M / 256 * 44) % G_, c_ = (int)blockIdx.x;
                    if (rem == 0 || c_ >= rem) { Args Aq = args; Aq.ws = wsq; const int t_ = opq_tid();
                        const int c0_ = rem == 0 ? 0 : rem;
                        const int w_ = (c_ - c0_) * NWAVES + __builtin_amdgcn_readfirstlane(t_ >> 6), nw_ = (G_ - c0_) * NWAVES;
                        convert_items(Aq, l, 16896 * s + 11264, 16896 * s + 16896, w_, nw_, t_ & 63);
                        const int xl = l + s, xlo = s ? 0 : 33792;
                        if (xl < DEPTH) convert_items(Aq, xl, xlo, xlo + CONV_TAIL_X, w_, nw_, t_ & 63); }
                }
                PH_END();
            } ++ph;
            if (PH_ON()) {
                unsigned char* wsq = opq(args.ws);
                pg8::Gemm g{(const pg8::bf16_t*)(wsq + WS_ACT), (const pg8::bf16_t*)(wsq + WS_WD) + (size_t)(l * 2 + s) * D * FF, M, D, FF};
                pg8::StaticOrder S; S.init(M, D, (int)gridDim.x, (int)blockIdx.x);
                pg8::EpiY16 E{(pg8::bf16_t*)(wsq + WS_Y), D};
                pg8::gemm_phase<pg8::EpiY16, pg8::StaticOrder, true, true>(L + RING_OFF, g, S, E);
                PH_END();
            } ++ph;
#endif
        } else {
#ifndef NO_GEMM
            if (PH_ON()) {
                unsigned char* wsq = opq(args.ws);
                pg8::Gemm g{(const pg8::bf16_t*)(wsq + WS_H), (const pg8::bf16_t*)(wsq + WS_WIN) + (size_t)l * NIN * D, M, NIN, D};
                pg8::StaticOrder S; S.init(M, NIN, (int)gridDim.x, (int)blockIdx.x);
                pg8::EpiQKV E{(pg8::bf16_t*)(wsq + WS_P), opq(args.out), l, (const float*)(wsq + WS_ROPE), opq(args.in[I_QN]), opq(args.in[I_KN]), (LAS float*)(L + NORM_OFF)};
                pg8::gemm_phase<pg8::EpiQKV, pg8::StaticOrder, true, true>(L + RING_OFF, g, S, E);
                PH_END();
            } ++ph;
#endif
                        #ifndef NO_ATTN
            if (PH_ON()) { attn_phase(A, l, (char*)lds, MISC); PH_END(); } ++ph;
#endif
#ifndef NO_GEMM
            if (PH_ON()) {
                unsigned char* wsq = opq(args.ws);
                pg8::Gemm g{(const pg8::bf16_t*)(wsq + WS_O), (const pg8::bf16_t*)(wsq + WS_WOUT) + (size_t)l * D * D, M, D, D};
                pg8::StaticOrder S; S.init(M, D, (int)gridDim.x, (int)blockIdx.x);
                pg8::EpiY16 E{(pg8::bf16_t*)(wsq + WS_Y), D};
                pg8::gemm_phase<pg8::EpiY16, pg8::StaticOrder, true, true>(L + RING_OFF, g, S, E);
                PH_END();
            } ++ph;
#endif
        }
#ifndef NO_T
        if (PH_ON()) { t1_phase(A, l, j, L); PH_END(); } ++ph;
#endif
    }
    if (blockIdx.x == 0 && threadIdx.x == 0 && hi >= ph) {
        if (__hip_atomic_load((gu32*)(ctl + CW_BAR + XB_TMO), RLX_AGENT) != 0u) args.out[0] = __builtin_nanf("");
    }
#undef PH_ON
#undef PH_END
}

extern "C" void kernel_launch(void* const* d_in, const int* in_sizes, int n_in, void* d_out, int out_size, void* d_ws, size_t ws_size, hipStream_t stream) {
    static int grid = 0;
    if (grid == 0) {
        if (n_in != 24 || in_sizes[0] != M_CTX * D || (size_t)out_size != OUT_TOTAL || ws_size < WS_END) {
            fprintf(stderr, "kernel_launch: shape mismatch: n_in %d in0 %d out %d ws %zu (need >= %zu)\n", n_in, n_in > 0 ? in_sizes[0] : -1, out_size, ws_size, (size_t)WS_END); grid = -1; return; }
        int dev = 0, cus = 0, per_cu = 0;
        if (hipGetDevice(&dev) != hipSuccess || hipDeviceGetAttribute(&cus, hipDeviceAttributeMultiprocessorCount, dev) != hipSuccess) { grid = -1; return; }
        if (hipFuncSetAttribute((const void*)fwd, hipFuncAttributeMaxDynamicSharedMemorySize, LDS_BYTES) != hipSuccess) { fprintf(stderr, "kernel_launch: hipFuncSetAttribute failed\n"); grid = -1; return; }
        if (hipOccupancyMaxActiveBlocksPerMultiprocessor(&per_cu, (const void*)fwd, NWAVES * 64, LDS_BYTES) != hipSuccess || per_cu < 1)
            fprintf(stderr, "kernel_launch: note: occupancy query reports %d workgroups per CU\n", per_cu);
        (void)hipGetLastError();
        grid = cus;
    }
    if (grid < 0) return;
    if (hipMemsetAsync((char*)d_ws + WS_CTL, 0, CTL_ZERO_BYTES, stream) != hipSuccess) { fprintf(stderr, "kernel_launch: memset failed\n"); return; }
    Args a{};
    for (int i = 0; i < 24; ++i) a.in[i] = (const float*)d_in[i];
    a.out = (float*)d_out; a.ws = (unsigned char*)d_ws; a.ph_lo = 0; a.ph_hi = NPH;
    hipLaunchKernelGGL(fwd, dim3(grid), dim3(NWAVES * 64), LDS_BYTES, stream, a);
    const hipError_t le = hipPeekAtLastError();
    if (le != hipSuccess) fprintf(stderr, "kernel_launch: launch failed: %s\n", hipGetErrorName(le));
}
```
